# Optimizing an MI355X kernel written in HIP

```python
import jax, jax.numpy as jnp
from jax import lax
import numpy as np

D_MODEL = 2048
BATCH = 4
SEQ = 4096
DEPTH = 1

C_CONV = D_MODEL // 2
C_POOL = D_MODEL // 2
CONV_WIDTH = 31
POOL_WINDOWS = (2, 4, 8, 16)
N_POOL_GROUPS = len(POOL_WINDOWS)
POOL_GROUP_DIM = C_POOL // N_POOL_GROUPS
W_IN_COLS = 2 * C_CONV + C_POOL + 2 * D_MODEL
N_EXPERTS = 32
TOP_K = 4
D_EXPERT = D_MODEL
SWIGLU_ALPHA = 1.702
SWIGLU_LIMIT = 7.0
NORM_EPS = 1e-5

kernel_name = "hybrid_conv_pool_gated_moe_block"


def rmsnorm(x, g):
    x32 = x.astype(jnp.float32)
    y = x32 * lax.rsqrt(jnp.mean(x32 * x32, axis=-1, keepdims=True) + NORM_EPS)
    return (y * g.astype(jnp.float32)).astype(x.dtype)


def layernorm(x, g, b):
    x32 = x.astype(jnp.float32)
    mu = jnp.mean(x32, axis=-1, keepdims=True)
    var = jnp.mean(jnp.square(x32 - mu), axis=-1, keepdims=True)
    y = (x32 - mu) * lax.rsqrt(var + NORM_EPS)
    return (y * g.astype(jnp.float32) + b.astype(jnp.float32)).astype(x.dtype)


def causal_depthwise_conv(u, w, b):
    y = lax.conv_general_dilated(
        u, w[:, None, :].astype(u.dtype), window_strides=(1,),
        padding=[(CONV_WIDTH - 1, 0)],
        dimension_numbers=("NWC", "WIO", "NWC"),
        feature_group_count=u.shape[-1])
    return y + b


def conformer_conv_branch(a, gate_in, conv_w, conv_b, ln_g, ln_b):
    u = a * jax.nn.sigmoid(gate_in)
    u = causal_depthwise_conv(u, conv_w, conv_b)
    u = layernorm(u, ln_g, ln_b)
    return jax.nn.silu(u)


def multiscale_pool_branch(p, pool_w, pool_scale):
    B, S, _ = p.shape
    pg = p.reshape(B, S, N_POOL_GROUPS, POOL_GROUP_DIM)
    cs = jnp.cumsum(pg.astype(jnp.float32), axis=1)
    pos = jnp.arange(1, S + 1, dtype=jnp.float32)[None, :, None]
    means = []
    for gi, w in enumerate(POOL_WINDOWS):
        c = cs[:, :, gi]
        lo = jnp.pad(c[:, :S - w], ((0, 0), (w, 0), (0, 0)))
        means.append((c - lo) / jnp.minimum(pos, float(w)))
    pooled = jnp.stack(means, axis=2)
    diff = (pooled - pg.astype(jnp.float32)).astype(p.dtype)
    y = jnp.einsum("bsgc,gcd->bsgd", diff, pool_w).reshape(B, S, C_POOL)
    return y * pool_scale


def gated_mixer(xn, w_in, conv_w, conv_b, conv_ln_g, conv_ln_b, w_conv_out,
                pool_w, pool_scale, w_pool_out, w_o):
    h = xn @ w_in
    o1 = C_CONV
    o2 = o1 + C_CONV
    o3 = o2 + C_POOL
    o4 = o3 + D_MODEL
    a, a_gate, p = h[..., :o1], h[..., o1:o2], h[..., o2:o3]
    g_conv, g_pool = h[..., o3:o4], h[..., o4:]
    y_conv = conformer_conv_branch(a, a_gate, conv_w, conv_b, conv_ln_g, conv_ln_b) @ w_conv_out
    y_pool = multiscale_pool_branch(p, pool_w, pool_scale) @ w_pool_out
    merged = jax.nn.sigmoid(g_conv) * y_conv + jax.nn.sigmoid(g_pool) * y_pool
    return merged @ w_o


def clamped_swiglu(h):
    x_glu, x_lin = jnp.split(h, 2, axis=-1)
    x_glu = jnp.minimum(x_glu, SWIGLU_LIMIT)
    x_lin = jnp.clip(x_lin, -SWIGLU_LIMIT, SWIGLU_LIMIT)
    return x_glu * jax.nn.sigmoid(SWIGLU_ALPHA * x_glu) * (x_lin + 1.0)


def moe_ffn(xn, w_router, b_router, w1, b1, w2, b2):
    B, S, D = xn.shape
    t = xn.reshape(B * S, D)
    logits = (t @ w_router + b_router).astype(jnp.float32)
    top_val, top_idx = lax.top_k(logits, TOP_K)
    top_w = jax.nn.softmax(top_val, axis=-1)
    gates = jnp.einsum("tk,tke->te", top_w,
                       jax.nn.one_hot(top_idx, N_EXPERTS, dtype=jnp.float32)).astype(t.dtype)
    out = jnp.zeros_like(t)
    for e in range(N_EXPERTS):
        act = clamped_swiglu(t @ w1[e] + b1[e])
        out = out + gates[:, e:e + 1] * (act @ w2[e] + b2[e])
    return out.reshape(B, S, D)


def setup_inputs(seed: int = 0) -> dict:
    key = jax.random.key(seed)
    ks = jax.random.split(key, 24)
    f32 = jnp.float32
    nrm = lambda k, shape, scale: jax.random.normal(k, shape, f32) * scale
    L = DEPTH
    return {
        "x": jax.random.normal(ks[0], (BATCH, SEQ, D_MODEL), f32),
        "norm_mix_g": 1.0 + nrm(ks[1], (L, D_MODEL), 0.02),
        "w_in": nrm(ks[2], (L, D_MODEL, W_IN_COLS), D_MODEL ** -0.5),
        "conv_w": nrm(ks[3], (L, CONV_WIDTH, C_CONV), CONV_WIDTH ** -0.5),
        "conv_b": nrm(ks[4], (L, C_CONV), 0.01),
        "conv_ln_g": 1.0 + nrm(ks[5], (L, C_CONV), 0.02),
        "conv_ln_b": nrm(ks[6], (L, C_CONV), 0.01),
        "w_conv_out": nrm(ks[7], (L, C_CONV, D_MODEL), C_CONV ** -0.5),
        "pool_w": nrm(ks[8], (L, N_POOL_GROUPS, POOL_GROUP_DIM, POOL_GROUP_DIM), POOL_GROUP_DIM ** -0.5),
        "pool_scale": 1.0 + nrm(ks[9], (L, C_POOL), 0.1),
        "w_pool_out": nrm(ks[10], (L, C_POOL, D_MODEL), C_POOL ** -0.5),
        "w_o": nrm(ks[11], (L, D_MODEL, D_MODEL), D_MODEL ** -0.5),
        "norm_ffn_g": 1.0 + nrm(ks[12], (L, D_MODEL), 0.02),
        "w_router": nrm(ks[13], (L, D_MODEL, N_EXPERTS), D_MODEL ** -0.5),
        "b_router": nrm(ks[14], (L, N_EXPERTS), 0.01),
        "w1": nrm(ks[15], (L, N_EXPERTS, D_MODEL, 2 * D_EXPERT), D_MODEL ** -0.5),
        "b1": nrm(ks[16], (L, N_EXPERTS, 2 * D_EXPERT), 0.01),
        "w2": nrm(ks[17], (L, N_EXPERTS, D_EXPERT, D_MODEL), D_EXPERT ** -0.5),
        "b2": nrm(ks[18], (L, N_EXPERTS, D_MODEL), 0.01),
        "norm_final_g": 1.0 + nrm(ks[19], (D_MODEL,), 0.02),
    }


def reference(x, norm_mix_g, w_in, conv_w, conv_b, conv_ln_g, conv_ln_b, w_conv_out,
              pool_w, pool_scale, w_pool_out, w_o, norm_ffn_g, w_router, b_router,
              w1, b1, w2, b2, norm_final_g):
    h = x
    for l in range(DEPTH):
        xn = rmsnorm(h, norm_mix_g[l])
        h = h + gated_mixer(xn, w_in[l], conv_w[l], conv_b[l], conv_ln_g[l], conv_ln_b[l],
                            w_conv_out[l], pool_w[l], pool_scale[l], w_pool_out[l], w_o[l])
        xn = rmsnorm(h, norm_ffn_g[l])
        h = h + moe_ffn(xn, w_router[l], b_router[l], w1[l], b1[l], w2[l], b2[l])
    return rmsnorm(h, norm_final_g)
```

```cpp
#include <hip/hip_runtime.h>
#include <cstdio>
#include <cstdint>

#ifndef N_LAUNCHES
#define N_LAUNCHES 1
#endif

#define LAS __attribute__((address_space(3)))
#define GAS __attribute__((address_space(1)))
typedef unsigned short bf16_t;
typedef short bf16x8 __attribute__((ext_vector_type(8)));
typedef float f32x4 __attribute__((ext_vector_type(4)));
typedef float f32x2 __attribute__((ext_vector_type(2)));
typedef unsigned u32x4 __attribute__((ext_vector_type(4)));
typedef unsigned u32x2 __attribute__((ext_vector_type(2)));
typedef int i32x8 __attribute__((ext_vector_type(8)));
typedef int i32x4 __attribute__((ext_vector_type(4)));

constexpr int T = 16384, SEQ = 4096, D = 2048, CC = 1024, NIN = 7168, NE = 32, DE = 2048;
constexpr float EPS = 1e-5f;
constexpr float YSCALE = 16.0f;
constexpr float XS = 8.0f;
constexpr float WSCALE = 32.0f;
constexpr int LCAP = 16384;
constexpr int MAXSLOT = 73728;

constexpr size_t MiB = 1u << 20;
constexpr size_t WS_CTL = 0, CTL_ZERO_BYTES = 1 * MiB;
constexpr size_t WS_RS1 = 1 * MiB;
constexpr size_t WS_SSQP = 2 * MiB;
constexpr size_t WS_WRT = 4 * MiB;
constexpr size_t WS_ONES = 4 * MiB + 512 * 1024;
constexpr size_t WS_SLOTREF = 5 * MiB;
constexpr size_t WS_LTOK = 6 * MiB;
constexpr size_t WS_LGATE = 8 * MiB;
constexpr size_t WS_LRS = 10 * MiB;
constexpr size_t WS_WPW = 12 * MiB;
constexpr size_t WS_WCO = 13 * MiB;
constexpr size_t WS_WPO = 17 * MiB;
constexpr size_t WS_WO = 21 * MiB;
constexpr size_t WS_WIN = 32 * MiB;
constexpr size_t WS_WIN8 = 48 * MiB;
constexpr size_t WS_XB8 = 544 * MiB;
constexpr size_t WS_XB = 64 * MiB;
constexpr size_t WS_U = 128 * MiB;
constexpr size_t WS_P = 160 * MiB;
constexpr size_t WS_G = 192 * MiB;
constexpr size_t WS_AC = 320 * MiB;
constexpr size_t WS_DP = 352 * MiB;
constexpr size_t WS_YP = 384 * MiB;
constexpr size_t WS_MG = 416 * MiB;
constexpr size_t WS_H = 480 * MiB;
constexpr size_t WS_HB = 608 * MiB;
constexpr size_t WS_W1 = 704 * MiB;
constexpr size_t WS_W2 = 1216 * MiB;
constexpr size_t WS_ACT = 1472 * MiB;
constexpr size_t WS_Y = 1760 * MiB;
constexpr size_t WS_END = 2048 * MiB;
constexpr int CW_BAR = 4096;
constexpr int CW_CNT = 16384;
constexpr int CW_QHEAD = 32768;

constexpr int STAGE_BYTES = 131072;
constexpr int L_MISC = STAGE_BYTES;
constexpr int L_CNT = L_MISC + 256;
constexpr int L_BASE = L_CNT + 128;
constexpr int L_NRT = L_BASE + 128;
constexpr int L_NU = L_NRT + 128;
constexpr int L_UNITS = L_NU + 16;
constexpr int L_TBL = STAGE_BYTES + 4096;
constexpr int LDS_BYTES = STAGE_BYTES + 8192;
constexpr int NTHREADS = 512, NWAVES = 8;

__device__ __forceinline__ unsigned f2bf(float f) { unsigned u = __builtin_bit_cast(unsigned, f); return (u + 0x7fffu + ((u >> 16) & 1u)) >> 16; }
__device__ __forceinline__ float bf2f(unsigned b) { return __builtin_bit_cast(float, b << 16); }
__device__ __forceinline__ unsigned cvt_pk_bf16(float lo, float hi) { unsigned r; asm volatile("v_cvt_pk_bf16_f32 %0, %1, %2" : "=v"(r) : "v"(lo), "v"(hi)); return r; }
__device__ __forceinline__ unsigned pk4_fp8(float a, float b, float c, float d) { int w = __builtin_amdgcn_cvt_pk_fp8_f32(a, b, 0, false); w = __builtin_amdgcn_cvt_pk_fp8_f32(c, d, w, true); return (unsigned)w; }
__device__ __forceinline__ float bflo(unsigned w) { return __builtin_bit_cast(float, w << 16); }
__device__ __forceinline__ float bfhi(unsigned w) { return __builtin_bit_cast(float, w & 0xffff0000u); }
__device__ __forceinline__ float sigmoidf_(float x) { return __builtin_amdgcn_rcpf(1.0f + __builtin_amdgcn_exp2f(-1.44269504f * x)); }
__device__ __forceinline__ float wave_sum(float v) {
#pragma unroll
    for (int o = 1; o < 64; o <<= 1) v += __shfl_xor(v, o);
    return v;
}
__device__ __forceinline__ int tid_opaque() { int t = threadIdx.x; asm volatile("" : "+v"(t)); return t; }
#define LDS_WAIT() asm volatile("s_waitcnt lgkmcnt(0)" ::: "memory")
#define VM_WAIT() asm volatile("s_waitcnt vmcnt(0)" ::: "memory")

#define XB_TMO      128
#define XB_XCNT(j)  (256  + 64 * (j))
#define XB_XSUB(j)  (1280 + 64 * (j))
#define XB_XGEN(j)  (2304 + 64 * (j))
#define XB_TOP      3328
#define XB_TOPGEN   3392
#define XCD_BAR_WORDS 3456
#define XB_SPIN_CAP (1u << 18)
__device__ __forceinline__ unsigned xb_ld(unsigned* p)              { return __hip_atomic_load(p, __ATOMIC_RELAXED, __HIP_MEMORY_SCOPE_AGENT); }
__device__ __forceinline__ unsigned xb_add(unsigned* p, unsigned v) { return __hip_atomic_fetch_add(p, v, __ATOMIC_RELAXED, __HIP_MEMORY_SCOPE_AGENT); }
__device__ __forceinline__ unsigned xb_xcc_id() { return (unsigned)__builtin_amdgcn_s_getreg((3 << 11) | 20) & 0xFu; }
#define XB_SPIN(cond, bar) do { unsigned _sp = 0; while (cond) { __builtin_amdgcn_s_sleep(1); \
    if ((++_sp & 255u) == 0u) { if (xb_ld(&(bar)[XB_TMO])) break; if (_sp > XB_SPIN_CAP) { atomicAdd(&(bar)[XB_TMO], 1u); break; } } } } while (0)
struct XcdBarrier { unsigned* bar; unsigned x; volatile LAS unsigned* st; };
__device__ __forceinline__ XcdBarrier xcd_barrier_post(unsigned* bar, volatile LAS unsigned* st) {
    XcdBarrier b; b.bar = bar; b.x = xb_xcc_id(); b.st = st;
    if (threadIdx.x == 0) (void)xb_add(&bar[XB_XCNT(b.x)], 1u);
    return b;
}
__device__ __forceinline__ void xcd_barrier_complete(unsigned* bar, unsigned x, unsigned& nloc, unsigned& nx) {
    const unsigned G = gridDim.x * gridDim.y * gridDim.z;
    unsigned sum, cnt, mine, sp = 0u;
    for (;;) {
        sum = 0u; cnt = 0u; mine = 0u;
#pragma unroll
        for (unsigned j = 0; j < 16; ++j) { const unsigned c = xb_ld(&bar[XB_XCNT(j)]); sum += c; cnt += (c > 0u) ? 1u : 0u; mine = (j == x) ? c : mine; }
        if (sum == G) break;
        __builtin_amdgcn_s_sleep(1);
        if ((++sp & 255u) == 0u) { if (xb_ld(&bar[XB_TMO])) break; if (sp > XB_SPIN_CAP) { atomicAdd(&bar[XB_TMO], 1u); break; } }
    }
    nloc = mine > 0u ? mine : 1u; nx = cnt > 0u ? cnt : 1u;
}
__device__ __forceinline__ void xcd_barrier(const XcdBarrier& b) {
    asm volatile("s_waitcnt vmcnt(0)" ::: "memory");
    __syncthreads();
    if (threadIdx.x == 0) {
        unsigned* bar = b.bar;
        __builtin_amdgcn_s_waitcnt(0);
        unsigned nloc = b.st[0], nx = b.st[1];
        if (nloc == 0u) { xcd_barrier_complete(bar, b.x, nloc, nx); b.st[0] = nloc; b.st[1] = nx; }
        const unsigned old = xb_add(&bar[XB_XSUB(b.x)], 1u);
        const unsigned gen = old / nloc;
        if (old + 1u == (gen + 1u) * nloc) {
            __builtin_amdgcn_fence(__ATOMIC_RELEASE, "agent");
            asm volatile("s_waitcnt vmcnt(0)" ::: "memory");
            const unsigned og = xb_add(&bar[XB_TOP], 1u);
            const unsigned tg = og / nx;
            if (og + 1u == (tg + 1u) * nx) xb_add(&bar[XB_TOPGEN], 1u);
            else XB_SPIN(xb_ld(&bar[XB_TOPGEN]) == tg, bar);
            __builtin_amdgcn_fence(__ATOMIC_ACQUIRE, "agent");
            xb_add(&bar[XB_XGEN(b.x)], 1u);
            asm volatile("s_waitcnt vmcnt(0)" ::: "memory");
        } else {
            XB_SPIN(xb_ld(&bar[XB_XGEN(b.x)]) == gen, bar);
            __builtin_amdgcn_fence(__ATOMIC_ACQUIRE, "agent");
            asm volatile("s_waitcnt vmcnt(0)" ::: "memory");
        }
    }
    __syncthreads();
}

constexpr int BM = 256, BK = 64, HALF = 128, HTB = HALF * BK * 2, NXCD = 8, WGM = 8;
__host__ __device__ __forceinline__ int lds_byte(int r, int c) { const int st = (r >> 4) * 2 + (c >> 5), rr = r & 15, cc = c & 31, ob = rr * 64 + cc * 2; return st * 1024 + (ob ^ (((ob >> 9) & 1) << 5)); }
__host__ __device__ __forceinline__ void stage_rc(int b, int& R, int& C) { const int st = b / 1024, sb = b % 1024, swz = sb ^ (((sb >> 9) & 1) << 5); R = (st >> 1) * 16 + swz / 64; C = (st & 1) * 32 + (swz % 64) / 2; }
__host__ __device__ __forceinline__ int perm32(int rho) { const int n = rho >> 4, i = rho & 15; return 8 * (i >> 2) + 4 * n + (i & 3); }

struct UnitD { const char* A; const char* B; int i0, i1, i2, i3; };

struct TileOrder {
    int nM, nN, nwg;
    __device__ __forceinline__ void init(int M, int N) { nM = M / BM; nN = N / BM; nwg = nM * nN; }
    __device__ __forceinline__ bool get(int L, int& pm, int& pn) const {
        if (L >= nwg) return false;
        int wgid = L; { const int q = nwg / NXCD, r = nwg % NXCD, xcd = wgid % NXCD, off = wgid / NXCD; wgid = (xcd < r ? xcd * (q + 1) : r * (q + 1) + (xcd - r) * q) + off; }
        const int nig = WGM * nN, gid = wgid / nig, fm = gid * WGM, gsz = (nM - fm) < WGM ? (nM - fm) : WGM;
        pm = fm + ((wgid % nig) % gsz); pn = (wgid % nig) / gsz; return true;
    }
};

template <class Epi, class Sched, bool GATHER, bool FP8>
__device__ __forceinline__ void gemm_phase(LAS unsigned char* lds, const int KB, const int pitchB, const Sched& S, const Epi& E) {
    const int tid = tid_opaque(), wid = __builtin_amdgcn_readfirstlane(tid >> 6), lane = tid & 63, wr = wid >> 2, wc = wid & 3, fr = lane & 15, fq = lane >> 4;
    int Kk = KB; asm volatile("" : "+s"(Kk));
    const int nt = Kk / 128;
    int Rr[2], Cc[2]; unsigned voffB[2];
#pragma unroll
    for (int i = 0; i < 2; ++i) { stage_rc(tid * 16 + i * 8192, Rr[i], Cc[i]);
        const int R = Rr[i], rho = R & 31; const int Rb = Epi::CMAP ? 64 * (R >> 5) + 16 * ((rho >> 2) & 3) + 4 * (rho >> 4) + (rho & 3) : (R & ~31) + perm32(rho);
        voffB[i] = (unsigned)(Rb * pitchB + Cc[i] * 2); }
    const size_t kstep = (size_t)(BK * 2);
    const size_t hstep = (size_t)(Epi::CMAP ? 8 : HALF) * pitchB;
    const unsigned ldsw = (unsigned)wid * 1024u;
    const int aoff = lds_byte(wr * 64 + fr, fq * 8), boff = lds_byte(wc * 32 + fr, fq * 8);
#define PG8_SA(b, h) (((b) * 2 + (h)) * HTB)
#define PG8_SB(b, h) ((4 + (b) * 2 + (h)) * HTB)
#define PG8_STAGE(bufoff, gbase, voff) do { _Pragma("unroll") for (int _i = 0; _i < 2; ++_i) \
        __builtin_amdgcn_global_load_lds((const unsigned*)((const char*)(gbase) + (voff)[_i]), (LAS unsigned*)(lds + (bufoff) + ldsw + _i * 8192), 16, 0, 0); } while (0)
#define PG8_LDA(dst, b, h) do { _Pragma("unroll") for (int m = 0; m < 4; ++m) _Pragma("unroll") for (int k = 0; k < 2; ++k) dst[m][k] = *(const LAS bf16x8*)(lds + PG8_SA(b, h) + aoff + m * 2048 + k * 1024); } while (0)
#define PG8_LDB(dst, b, h) do { _Pragma("unroll") for (int n = 0; n < 2; ++n) _Pragma("unroll") for (int k = 0; k < 2; ++k) dst[n][k] = *(const LAS bf16x8*)(lds + PG8_SB(b, h) + boff + n * 2048 + k * 1024); } while (0)
#define PG8_MMA(ai, bj, At, Bt) do { __builtin_amdgcn_s_setprio(1); _Pragma("unroll") for (int m = 0; m < 4; ++m) _Pragma("unroll") for (int n = 0; n < 2; ++n) { \
        if constexpr (FP8) { const i32x4 a0_ = __builtin_bit_cast(i32x4, At[m][0]), a1_ = __builtin_bit_cast(i32x4, At[m][1]), b0_ = __builtin_bit_cast(i32x4, Bt[n][0]), b1_ = __builtin_bit_cast(i32x4, Bt[n][1]); \
            const i32x8 a_ = __builtin_shufflevector(a0_, a1_, 0, 1, 2, 3, 4, 5, 6, 7), b_ = __builtin_shufflevector(b0_, b1_, 0, 1, 2, 3, 4, 5, 6, 7); \
            asm volatile("s_nop 1\n\tv_mfma_f32_16x16x128_f8f6f4 %0, %1, %2, %0" : "+v"(acc[ai][bj][m][n]) : "v"(b_), "v"(a_)); } \
        else { _Pragma("unroll") for (int k = 0; k < 2; ++k) acc[ai][bj][m][n] = __builtin_amdgcn_mfma_f32_16x16x32_bf16(Bt[n][k], At[m][k], acc[ai][bj][m][n], 0, 0, 0); } } \
        __builtin_amdgcn_s_setprio(0); } while (0)
#define PG8_WAIT_V(n) asm volatile("s_waitcnt vmcnt(" #n ")" ::: "memory")
#define PG8_WAIT_L(n) asm volatile("s_waitcnt lgkmcnt(" #n ")" ::: "memory")
#define PG8_BAR __builtin_amdgcn_s_barrier()
#define PG8_SCHED __builtin_amdgcn_sched_barrier(0)
    UnitD cur, nxt; int ui = 0;
    if (!S.next(0, cur)) return;
    unsigned vA[2][2], vN[2][2];
#pragma unroll
    for (int h = 0; h < 2; ++h)
#pragma unroll
        for (int i = 0; i < 2; ++i) { vA[h][i] = S.a_off(cur, h, Rr[i], Cc[i]); vN[h][i] = vA[h][i]; }
    f32x4 acc[2][2][4][2];
#pragma unroll
    for (int a = 0; a < 2; ++a)
#pragma unroll
        for (int b = 0; b < 2; ++b)
#pragma unroll
            for (int m = 0; m < 4; ++m)
#pragma unroll
                for (int n = 0; n < 2; ++n) acc[a][b][m][n] = (f32x4){0.f, 0.f, 0.f, 0.f};
    bf16x8 At[4][2], B0[2][2], B1[2][2];
    const char* cA = cur.A; const char* cB = cur.B;
    PG8_STAGE(PG8_SB(0, 0), cB, voffB); PG8_STAGE(PG8_SB(0, 1), cB + hstep, voffB); PG8_STAGE(PG8_SA(0, 0), cA, vA[0]); PG8_STAGE(PG8_SA(0, 1), cA, vA[1]);
    if (wr == 1) PG8_BAR;
    PG8_WAIT_V(2); PG8_BAR;
    PG8_STAGE(PG8_SB(1, 0), cB + kstep, voffB); PG8_STAGE(PG8_SA(1, 0), cA + kstep, vA[0]); PG8_STAGE(PG8_SB(1, 1), cB + hstep + kstep, voffB);
    PG8_WAIT_V(6); PG8_BAR;
    for (;;) {
        const bool has_next = S.next(ui + 1, nxt);
        bool do0 = true, do1 = true;
        if constexpr (Epi::RSKIP) { const int vr = cur.i3 - cur.i1 * 256; do0 = (64 * wr) < vr; do1 = (128 + 64 * wr) < vr; }
        float tv = E.tbl_fetch(cur, wid, lane);
        int rawN[2][2];
        if constexpr (GATHER) {
#pragma unroll
            for (int h = 0; h < 2; ++h)
#pragma unroll
                for (int i = 0; i < 2; ++i) rawN[h][i] = S.tok_fetch(has_next ? nxt : cur, h, Rr[i]);
        }
        const char* nA = has_next ? nxt.A : cA; const char* nB = has_next ? nxt.B : cB;
        for (int t = 0; t < nt; t += 2) {
            const bool last = (t == nt - 2);
            const char* a1 = cA + (size_t)(t + 1) * kstep;
            const char* a2 = last ? nA : cA + (size_t)(t + 2) * kstep; const char* b2 = last ? nB : cB + (size_t)(t + 2) * kstep;
            const char* a3 = a2 + kstep; const char* b3 = b2 + kstep;
            unsigned x0[2], x1[2];
            if constexpr (GATHER) {
                asm volatile("" : "+v"(rawN[0][0]), "+v"(rawN[0][1]), "+v"(rawN[1][0]), "+v"(rawN[1][1]));
#pragma unroll
                for (int h = 0; h < 2; ++h)
#pragma unroll
                    for (int i = 0; i < 2; ++i) vN[h][i] = S.tok_off(has_next ? nxt : cur, h, Rr[i], Cc[i], rawN[h][i]);
                x0[0] = last ? vN[0][0] : vA[0][0]; x0[1] = last ? vN[0][1] : vA[0][1]; x1[0] = last ? vN[1][0] : vA[1][0]; x1[1] = last ? vN[1][1] : vA[1][1]; }
            else { x0[0] = vA[0][0]; x0[1] = vA[0][1]; x1[0] = vA[1][0]; x1[1] = vA[1][1]; }
            PG8_LDB(B0, 0, 0); PG8_LDB(B1, 0, 1); PG8_SCHED; if (do0) { PG8_LDA(At, 0, 0); } PG8_STAGE(PG8_SA(1, 1), a1, vA[1]);
            PG8_WAIT_V(8); PG8_WAIT_L(0); PG8_BAR; if (do0) { PG8_MMA(0, 0, At, B0); PG8_MMA(0, 1, At, B1); } PG8_BAR; PG8_SCHED;
            if (do1) { PG8_LDA(At, 0, 1); } PG8_STAGE(PG8_SB(0, 0), b2, voffB); PG8_STAGE(PG8_SB(0, 1), b2 + hstep, voffB); PG8_STAGE(PG8_SA(0, 0), a2, x0);
            PG8_WAIT_V(8); PG8_WAIT_L(0); PG8_BAR; if (do1) { PG8_MMA(1, 0, At, B0); PG8_MMA(1, 1, At, B1); } PG8_BAR; PG8_SCHED;
            PG8_LDB(B0, 1, 0); PG8_LDB(B1, 1, 1); PG8_SCHED; if (do0) { PG8_LDA(At, 1, 0); } PG8_STAGE(PG8_SA(0, 1), a2, x1);
            PG8_WAIT_V(8); PG8_WAIT_L(0); PG8_BAR; if (do0) { PG8_MMA(0, 0, At, B0); PG8_MMA(0, 1, At, B1); } PG8_BAR; PG8_SCHED;
            if (do1) { PG8_LDA(At, 1, 1); } PG8_STAGE(PG8_SB(1, 0), b3, voffB); PG8_STAGE(PG8_SB(1, 1), b3 + hstep, voffB); PG8_STAGE(PG8_SA(1, 0), a3, x0);
            PG8_WAIT_V(8); PG8_WAIT_L(0); PG8_BAR; if (do1) { PG8_MMA(1, 0, At, B0); PG8_MMA(1, 1, At, B1); } PG8_BAR; PG8_SCHED;
        }
        if (wr == 0) PG8_BAR;
        if constexpr (Epi::TBL) { E.tbl_put(tv, lds, wid, lane, ui & 1); PG8_WAIT_L(0); PG8_BAR; }
        if constexpr (FP8) asm volatile("s_nop 15\n\ts_nop 15" ::: "memory");
        E(acc, cur, wr, wc, fr, fq, ui & 1);
        if (!has_next) break;
        if (!E.keep(cur)) {
#pragma unroll
            for (int a = 0; a < 2; ++a)
#pragma unroll
                for (int b = 0; b < 2; ++b)
#pragma unroll
                    for (int m = 0; m < 4; ++m)
#pragma unroll
                        for (int n = 0; n < 2; ++n) acc[a][b][m][n] = (f32x4){0.f, 0.f, 0.f, 0.f};
        }
        cur = nxt; cA = nA; cB = nB; ++ui;
#pragma unroll
        for (int h = 0; h < 2; ++h)
#pragma unroll
            for (int i = 0; i < 2; ++i) vA[h][i] = vN[h][i];
        if (wr == 1) PG8_BAR;
    }
    PG8_WAIT_V(0);
    PG8_BAR;
#undef PG8_SA
#undef PG8_SB
#undef PG8_STAGE
#undef PG8_LDA
#undef PG8_LDB
#undef PG8_MMA
#undef PG8_WAIT_V
#undef PG8_WAIT_L
#undef PG8_BAR
#undef PG8_SCHED
}

struct Args { const float* in[20]; float* out; unsigned char* ws; int ph_lo, ph_hi, li, pad; };

#define CAS __attribute__((address_space(4)))
__device__ __forceinline__ const float* in_ptr(int i) { const CAS Args* ka = (const CAS Args*)__builtin_amdgcn_kernarg_segment_ptr(); asm volatile("" : "+s"(ka)); return ka->in[i]; }
__device__ __forceinline__ float* out_ptr() { const CAS Args* ka = (const CAS Args*)__builtin_amdgcn_kernarg_segment_ptr(); asm volatile("" : "+s"(ka)); return ka->out; }
struct Frame {
    LAS unsigned char* lds;
    unsigned char* ws;
    int G, bx;
};
#define PHASE_IDS() const int tid = tid_opaque(), lane = tid & 63, wave = __builtin_amdgcn_readfirstlane(tid >> 6); (void)lane; (void)wave

struct DenseSched {
    const char* A; const char* B; int lda, ldb, G, c; TileOrder to;
    __device__ __forceinline__ bool next(int i, UnitD& u) const {
        int pm, pn; if (!to.get(i * G + c, pm, pn)) return false;
        u.A = A + (size_t)pm * 256 * lda * 2; u.B = B + (size_t)pn * 256 * ldb * 2; u.i0 = pm; u.i1 = pn; u.i2 = 0; u.i3 = 0; return true;
    }
    __device__ __forceinline__ unsigned a_off(const UnitD&, int h, int R, int C) const { return (unsigned)((h * 128 + R) * lda + C) * 2u; }
};
struct DenseSched8 {
    const char* A; const char* B; int lda, ldb, G, c; TileOrder to;
    __device__ __forceinline__ bool next(int i, UnitD& u) const {
        int pm, pn; if (!to.get(i * G + c, pm, pn)) return false;
        u.A = A + (size_t)pm * 256 * lda; u.B = B + (size_t)pn * 256 * ldb; u.i0 = pm; u.i1 = pn; u.i2 = 0; u.i3 = 0; return true;
    }
    __device__ __forceinline__ unsigned a_off(const UnitD&, int h, int R, int C) const { return (unsigned)((h * 128 + R) * lda + C * 2); }
};
struct PoolSched {
    const char* A; const char* B; int G, c;
    __device__ __forceinline__ bool next(int i, UnitD& u) const {
        const int L = i * G + c; if (L >= 32) return false;
        const int pm = L >> 2, g = L & 3;
        u.A = A + ((size_t)pm * 256 * CC + g * 256) * 2; u.B = B + (size_t)g * 65536 * 2; u.i0 = pm; u.i1 = g; u.i2 = 0; u.i3 = 0; return true;
    }
    __device__ __forceinline__ unsigned a_off(const UnitD&, int h, int R, int C) const { return (unsigned)((h * 128 + R) * CC + C) * 2u; }
};
struct MergeSched {
    const char* A0; const char* A1; const char* B0; const char* B1; int G, c; TileOrder to;
    __device__ __forceinline__ bool next(int i, UnitD& u) const {
        int pm, pn; if (!to.get((i >> 1) * G + c, pm, pn)) return false;
        const int part = i & 1;
        u.A = (part ? A1 : A0) + (size_t)pm * 256 * CC * 2; u.B = (part ? B1 : B0) + (size_t)pn * 256 * CC * 2; u.i0 = pm; u.i1 = pn; u.i2 = part; u.i3 = 0; return true;
    }
    __device__ __forceinline__ unsigned a_off(const UnitD&, int h, int R, int C) const { return (unsigned)((h * 128 + R) * CC + C) * 2u; }
};
struct MoeSched {
    LAS unsigned char* lds; const char* A; const char* B; const int* ltok; int gather; int nrows_w;
    __device__ __forceinline__ bool next(int i, UnitD& u) const {
        const int nu = __builtin_amdgcn_readfirstlane(((const LAS int*)(lds + L_NU))[0]); if (i >= nu) return false;
        const int code = __builtin_amdgcn_readfirstlane(((const LAS int*)(lds + L_UNITS))[i]); const int e = code >> 16, rt = (code >> 8) & 0xff, ct = code & 0xff;
        const int cnt = __builtin_amdgcn_readfirstlane(((const LAS int*)(lds + L_CNT))[e]), base = __builtin_amdgcn_readfirstlane(((const LAS int*)(lds + L_BASE))[e]);
        u.A = gather ? A : A + (size_t)(base + rt * 256) * DE;
        u.B = B + ((size_t)e * nrows_w + (size_t)ct * 256) * DE;
        u.i0 = e; u.i1 = rt; u.i2 = ct; u.i3 = cnt; return true;
    }
    __device__ __forceinline__ int tok_fetch(const UnitD& u, int h, int R) const {
        int v; const int* p = ltok + u.i0 * LCAP + u.i1 * 256 + h * 128 + R; asm volatile("global_load_dword %0, %1, off" : "=v"(v) : "v"(p) : "memory"); return v; }
    __device__ __forceinline__ unsigned tok_off(const UnitD& u, int h, int R, int C, int raw) const {
        const int sr = u.i1 * 256 + h * 128 + R; const int tok = (sr < u.i3) ? raw : 0; return (unsigned)(tok * DE + C * 2); }
    __device__ __forceinline__ unsigned a_off(const UnitD& u, int h, int R, int C) const {
        if (gather) { const int sr = u.i1 * 256 + h * 128 + R; const int tok = (sr < u.i3) ? ltok[u.i0 * LCAP + sr] : 0; return (unsigned)(tok * DE + C * 2); }
        return (unsigned)((h * 128 + R) * DE + C * 2);
    }
};

#define EPI_FENCE() asm volatile("" ::: "memory")
__device__ __forceinline__ u32x4 pack8(const f32x4 a, const f32x4 b) { u32x4 w; w.x = cvt_pk_bf16(a[0], a[1]); w.y = cvt_pk_bf16(a[2], a[3]); w.z = cvt_pk_bf16(b[0], b[1]); w.w = cvt_pk_bf16(b[2], b[3]); return w; }
__device__ __forceinline__ f32x4 sig4(const f32x4 v) { return (f32x4){sigmoidf_(v[0]), sigmoidf_(v[1]), sigmoidf_(v[2]), sigmoidf_(v[3])}; }
__device__ __forceinline__ void unpack8(const u32x4 w, f32x4& a, f32x4& b) { a = (f32x4){bflo(w.x), bfhi(w.x), bflo(w.y), bfhi(w.y)}; b = (f32x4){bflo(w.z), bfhi(w.z), bflo(w.w), bfhi(w.w)}; }

__device__ __forceinline__ float tbl_load(const float* g, int lane) { float v; const float* p = g + lane; asm volatile("global_load_dword %0, %1, off" : "=v"(v) : "v"(p) : "memory"); return v; }
__device__ __forceinline__ void tbl_store(float v, LAS unsigned char* lds, int par, int slot, int lane) { asm volatile("" : "+v"(v)); ((LAS float*)(lds + L_TBL + par * 2048 + slot * 256))[lane] = v; }
struct EpiWin {
    bf16_t* U; bf16_t* P; const float* rs1;
    LAS unsigned char* lds;
    __device__ __forceinline__ float tbl_fetch(const UnitD& u, int wid, int lane) const { return tbl_load(rs1 + u.i0 * 256 + (wid & 3) * 64, lane); }
    __device__ __forceinline__ void tbl_put(float v, LAS unsigned char* l, int wid, int lane, int par) const { if (wid < 4) tbl_store(v, l, par, wid, lane); }
    static constexpr int CMAP = 0;
    static constexpr bool RSKIP = false;
    static constexpr bool TBL = true;
    __device__ __forceinline__ bool keep(const UnitD&) const { return false; }
    __device__ __forceinline__ void operator()(f32x4 (&acc)[2][2][4][2], const UnitD& u, int wr, int wc, int fr, int fq, int par) const {
        const int pm = u.i0, pn = u.i1; const int row0 = pm * 256 + wr * 64 + fr, cl = wc * 32 + 8 * fq;
        const LAS float* trs = (const LAS float*)(lds + L_TBL + par * 2048) + wr * 64 + fr;
        if (pn < 8) {
#pragma unroll
            for (int ai = 0; ai < 2; ++ai)
#pragma unroll
                for (int m = 0; m < 4; ++m) { const int r = row0 + ai * 128 + m * 16; const float rs = trs[ai * 128 + m * 16];
                    const f32x4 a0 = acc[ai][0][m][0] * rs, a1 = acc[ai][0][m][1] * rs, g0 = acc[ai][1][m][0] * rs, g1 = acc[ai][1][m][1] * rs;
                    *(u32x4*)(U + (size_t)r * CC + pn * 128 + cl) = pack8(a0 * sig4(g0), a1 * sig4(g1)); }
        } else {
#pragma unroll
            for (int ai = 0; ai < 2; ++ai)
#pragma unroll
                for (int m = 0; m < 4; ++m) { const int r = row0 + ai * 128 + m * 16; const float rs = trs[ai * 128 + m * 16];
#pragma unroll
                    for (int bj = 0; bj < 2; ++bj) *(u32x4*)(P + (size_t)r * CC + (pn - 8) * 256 + bj * 128 + cl) = pack8(acc[ai][bj][m][0] * rs, acc[ai][bj][m][1] * rs); }
        }
    }
};
struct EpiGate {
    bf16_t* Gt; const float* rs1;
    LAS unsigned char* lds;
    __device__ __forceinline__ float tbl_fetch(const UnitD& u, int wid, int lane) const { return tbl_load(rs1 + u.i0 * 256 + (wid & 3) * 64, lane); }
    __device__ __forceinline__ void tbl_put(float v, LAS unsigned char* l, int wid, int lane, int par) const { if (wid < 4) tbl_store(v, l, par, wid, lane); }
    static constexpr int CMAP = 0;
    static constexpr bool RSKIP = false;
    static constexpr bool TBL = true;
    __device__ __forceinline__ bool keep(const UnitD&) const { return false; }
    __device__ __forceinline__ void operator()(f32x4 (&acc)[2][2][4][2], const UnitD& u, int wr, int wc, int fr, int fq, int par) const {
        const int pm = u.i0, pn = u.i1; const int row0 = pm * 256 + wr * 64 + fr, cl = wc * 32 + 8 * fq;
        const LAS float* trs = (const LAS float*)(lds + L_TBL + par * 2048) + wr * 64 + fr;
#pragma unroll
        for (int ai = 0; ai < 2; ++ai)
#pragma unroll
            for (int m = 0; m < 4; ++m) { const int r = row0 + ai * 128 + m * 16; const float rs = trs[ai * 128 + m * 16] * (1.0f / (WSCALE * XS));
                { const f32x4 c0 = sig4(acc[ai][0][m][0] * rs), c1 = sig4(acc[ai][0][m][1] * rs), p0 = sig4(acc[ai][1][m][0] * rs), p1 = sig4(acc[ai][1][m][1] * rs); f32x4 q0, q1;
#pragma unroll
                  for (int j = 0; j < 4; ++j) { q0[j] = c0[j] * __builtin_amdgcn_rcpf(fmaxf(p0[j], 1e-6f)); q1[j] = c1[j] * __builtin_amdgcn_rcpf(fmaxf(p1[j], 1e-6f)); }
                  __builtin_nontemporal_store(pack8(q0, q1), (u32x4*)(Gt + (size_t)r * 4096 + pn * 128 + cl));
                  __builtin_nontemporal_store(pack8(p0, p1), (u32x4*)(Gt + (size_t)r * 4096 + 2048 + pn * 128 + cl)); } }
    }
};
struct EpiPool {
    bf16_t* YP;
    __device__ __forceinline__ float tbl_fetch(const UnitD&, int, int) const { return 0.f; }
    __device__ __forceinline__ void tbl_put(float, LAS unsigned char*, int, int, int) const {}
    static constexpr int CMAP = 0;
    static constexpr bool RSKIP = false;
    static constexpr bool TBL = false;
    __device__ __forceinline__ bool keep(const UnitD&) const { return false; }
    __device__ __forceinline__ void operator()(f32x4 (&acc)[2][2][4][2], const UnitD& u, int wr, int wc, int fr, int fq, int par) const {
        const int pm = u.i0, g = u.i1; const int row0 = pm * 256 + wr * 64 + fr, cl = g * 256 + wc * 32 + 8 * fq;
#pragma unroll
        for (int ai = 0; ai < 2; ++ai)
#pragma unroll
            for (int m = 0; m < 4; ++m) { const int r = row0 + ai * 128 + m * 16;
#pragma unroll
                for (int bj = 0; bj < 2; ++bj) *(u32x4*)(YP + (size_t)r * CC + cl + bj * 128) = pack8(acc[ai][bj][m][0], acc[ai][bj][m][1]); }
    }
};
struct EpiMerge {
    bf16_t* MG; const bf16_t* Gt;
    __device__ __forceinline__ float tbl_fetch(const UnitD&, int, int) const { return 0.f; }
    __device__ __forceinline__ void tbl_put(float, LAS unsigned char*, int, int, int) const {}
    static constexpr int CMAP = 0;
    static constexpr bool RSKIP = false;
    static constexpr bool TBL = false;
    __device__ __forceinline__ bool keep(const UnitD& u) const { return u.i2 == 0; }
    __device__ __forceinline__ void operator()(f32x4 (&acc)[2][2][4][2], const UnitD& u, int wr, int wc, int fr, int fq, int par) const {
        const int pm = u.i0, pn = u.i1, part = u.i2; const int row0 = pm * 256 + wr * 64 + fr, cl = pn * 256 + wc * 32 + 8 * fq;
        if (part == 0) {
#pragma unroll
            for (int ai = 0; ai < 2; ++ai)
#pragma unroll
                for (int m = 0; m < 4; ++m) { const int r = row0 + ai * 128 + m * 16;
#pragma unroll
                    for (int bj = 0; bj < 2; ++bj) { const u32x4 wq_ = *(const u32x4*)(Gt + (size_t)r * 4096 + cl + bj * 128);
                        f32x4 q0, q1; unpack8(wq_, q0, q1); acc[ai][bj][m][0] = acc[ai][bj][m][0] * q0; acc[ai][bj][m][1] = acc[ai][bj][m][1] * q1; }
                    EPI_FENCE(); }
        } else {
#pragma unroll
            for (int ai = 0; ai < 2; ++ai)
#pragma unroll
                for (int m = 0; m < 4; ++m) { const int r = row0 + ai * 128 + m * 16;
#pragma unroll
                    for (int bj = 0; bj < 2; ++bj) { const u32x4 wp_ = *(const u32x4*)(Gt + (size_t)r * 4096 + 2048 + cl + bj * 128);
                        f32x4 p0, p1; unpack8(wp_, p0, p1);
#pragma unroll
                        for (int j = 0; j < 4; ++j) { p0[j] = fmaxf(p0[j], 1e-6f); p1[j] = fmaxf(p1[j], 1e-6f); }
                        *(u32x4*)(MG + (size_t)r * D + cl + bj * 128) = pack8(acc[ai][bj][m][0] * p0, acc[ai][bj][m][1] * p1); }
                    EPI_FENCE(); }
        }
    }
};
struct EpiWo {
    const bf16_t* x; bf16_t* H; unsigned char* HQ; float* SSQP; const float* g2;
    __device__ __forceinline__ float tbl_fetch(const UnitD&, int, int) const { return 0.f; }
    __device__ __forceinline__ void tbl_put(float, LAS unsigned char*, int, int, int) const {}
    static constexpr int CMAP = 1;
    static constexpr bool RSKIP = false;
    static constexpr bool TBL = false;
    __device__ __forceinline__ bool keep(const UnitD&) const { return false; }
    __device__ __forceinline__ void operator()(f32x4 (&acc)[2][2][4][2], const UnitD& u, int wr, int wc, int fr, int fq, int par) const {
        const int pm = u.i0, pn = u.i1; const int row0 = pm * 256 + wr * 64 + fr, cl = pn * 256 + wc * 64 + 16 * fq;
        f32x4 gg[4];
#pragma unroll
        for (int c = 0; c < 4; ++c) gg[c] = *(const f32x4*)(g2 + cl + 4 * c);
#pragma unroll
        for (int ai = 0; ai < 2; ++ai)
#pragma unroll
            for (int m = 0; m < 4; ++m) { const int r = row0 + ai * 128 + m * 16; const size_t o = (size_t)r * D + cl; float ss = 0.f;
                f32x4 h[4], xv[4]; { const u32x4 xa = *(const u32x4*)(x + o), xb2 = *(const u32x4*)(x + o + 8); unpack8(xa, xv[0], xv[1]); unpack8(xb2, xv[2], xv[3]); }
#pragma unroll
                for (int c = 0; c < 4; ++c) { h[c] = xv[c] + acc[ai][c >> 1][m][c & 1]; ss += (h[c][0] * h[c][0] + h[c][1] * h[c][1]) + (h[c][2] * h[c][2] + h[c][3] * h[c][3]); }
                *(u32x4*)(H + o) = pack8(h[0], h[1]); *(u32x4*)(H + o + 8) = pack8(h[2], h[3]);
                u32x4 q;
#pragma unroll
                for (int c = 0; c < 4; ++c) { const f32x4 t = h[c] * gg[c]; q[c] = pk4_fp8(t[0], t[1], t[2], t[3]); }
                *(u32x4*)(HQ + o) = q;
                ss += __shfl_xor(ss, 16); ss += __shfl_xor(ss, 32);
                if (fq == 0) SSQP[(size_t)r * 32 + pn * 4 + wc] = ss;
                EPI_FENCE(); }
    }
};
struct EpiMoe1 {
    unsigned char* ACT; const float* b1; const float* lrs; LAS unsigned char* lds;
    __device__ __forceinline__ float tbl_fetch(const UnitD& u, int wid, int lane) const {
        const float* g = (wid < 4) ? lrs + (size_t)u.i0 * LCAP + u.i1 * 256 + wid * 64 : b1 + (size_t)u.i0 * 4096 + u.i2 * 128 + ((wid >= 6) ? 2048 + (wid - 6) * 64 : (wid - 4) * 64);
        return tbl_load(g, lane); }
    __device__ __forceinline__ void tbl_put(float v, LAS unsigned char* l, int wid, int lane, int par) const { tbl_store(wid >= 6 ? v + 1.0f : v, l, par, wid, lane); }
    static constexpr int CMAP = 0;
    static constexpr bool RSKIP = true;
    static constexpr bool TBL = true;
    __device__ __forceinline__ bool keep(const UnitD&) const { return false; }
    __device__ __forceinline__ void operator()(f32x4 (&acc)[2][2][4][2], const UnitD& u, int wr, int wc, int fr, int fq, int par) const {
        const int e = u.i0, rt = u.i1, ct = u.i2, cnt = u.i3; const int base = __builtin_amdgcn_readfirstlane(((const LAS int*)(lds + L_BASE))[e]);
        const int sr0 = rt * 256 + wr * 64 + fr, cl = ct * 128 + wc * 32 + 8 * fq;
        const LAS float* tb = (const LAS float*)(lds + L_TBL + par * 2048);
        f32x4 bg[2], bl[2];
#pragma unroll
        for (int n = 0; n < 2; ++n) { bg[n] = *(const LAS f32x4*)(tb + 256 + wc * 32 + 8 * fq + 4 * n); bl[n] = *(const LAS f32x4*)(tb + 384 + wc * 32 + 8 * fq + 4 * n); }
#pragma unroll
        for (int ai = 0; ai < 2; ++ai) { if (ai * 128 + wr * 64 >= cnt - rt * 256) continue;
#pragma unroll
            for (int m = 0; m < 4; ++m) { const int sr = sr0 + ai * 128 + m * 16; const float rs = tb[ai * 128 + wr * 64 + m * 16 + fr] * (1.0f / WSCALE);
                f32x4 o[2];
                const f32x2 rs2 = (f32x2){rs, rs};
#pragma unroll
                for (int n = 0; n < 2; ++n)
#pragma unroll
                    for (int jp = 0; jp < 2; ++jp) {
                        const f32x2 ag = (f32x2){acc[ai][0][m][n][2 * jp], acc[ai][0][m][n][2 * jp + 1]}, al_ = (f32x2){acc[ai][1][m][n][2 * jp], acc[ai][1][m][n][2 * jp + 1]};
                        const f32x2 bg2 = (f32x2){bg[n][2 * jp], bg[n][2 * jp + 1]}, bl2 = (f32x2){bl[n][2 * jp], bl[n][2 * jp + 1]};
                        const f32x2 hg = __builtin_elementwise_fma(ag, rs2, bg2), hl = __builtin_elementwise_fma(al_, rs2, bl2);
                        f32x2 xg, xl; xg[0] = fminf(hg[0], 7.0f); xg[1] = fminf(hg[1], 7.0f); xl[0] = fminf(fmaxf(hl[0], -6.0f), 8.0f); xl[1] = fminf(fmaxf(hl[1], -6.0f), 8.0f);
                        const f32x2 t = xg * (-1.702f * 1.44269504f);
                        f32x2 ex; ex[0] = __builtin_amdgcn_exp2f(t[0]); ex[1] = __builtin_amdgcn_exp2f(t[1]);
                        const f32x2 dn = ex + 1.0f;
                        f32x2 rc; rc[0] = __builtin_amdgcn_rcpf(dn[0]); rc[1] = __builtin_amdgcn_rcpf(dn[1]);
                        const f32x2 ov = (xg * rc) * xl;
                        o[n][2 * jp] = ov[0]; o[n][2 * jp + 1] = ov[1]; }
                { u32x2 q; q.x = pk4_fp8(o[0][0], o[0][1], o[0][2], o[0][3]); q.y = pk4_fp8(o[1][0], o[1][1], o[1][2], o[1][3]); *(u32x2*)(ACT + (size_t)(base + sr) * DE + cl) = q; } } }
    }
};
struct EpiMoe2 {
    unsigned char* Y; const float* b2; const float* lgate; LAS unsigned char* lds;
    __device__ __forceinline__ float tbl_fetch(const UnitD& u, int wid, int lane) const {
        const float* g = (wid < 4) ? lgate + (size_t)u.i0 * LCAP + u.i1 * 256 + wid * 64 : b2 + (size_t)u.i0 * D + u.i2 * 256 + (wid - 4) * 64;
        return tbl_load(g, lane); }
    __device__ __forceinline__ void tbl_put(float v, LAS unsigned char* l, int wid, int lane, int par) const { tbl_store(v, l, par, wid, lane); }
    static constexpr int CMAP = 1;
    static constexpr bool RSKIP = true;
    static constexpr bool TBL = true;
    __device__ __forceinline__ bool keep(const UnitD&) const { return false; }
    __device__ __forceinline__ void operator()(f32x4 (&acc)[2][2][4][2], const UnitD& u, int wr, int wc, int fr, int fq, int par) const {
        const int e = u.i0, rt = u.i1, ct = u.i2; const int base = __builtin_amdgcn_readfirstlane(((const LAS int*)(lds + L_BASE))[e]);
        const int sr0 = rt * 256 + wr * 64 + fr, cl = ct * 256 + wc * 64 + 16 * fq;
        const LAS float* tb = (const LAS float*)(lds + L_TBL + par * 2048);
        f32x4 bb[2][2];
#pragma unroll
        for (int bj = 0; bj < 2; ++bj)
#pragma unroll
            for (int n = 0; n < 2; ++n) bb[bj][n] = *(const LAS f32x4*)(tb + 256 + wc * 64 + 16 * fq + 8 * bj + 4 * n);
#pragma unroll
        for (int ai = 0; ai < 2; ++ai) { if (ai * 128 + wr * 64 >= u.i3 - rt * 256) continue;
#pragma unroll
            for (int m = 0; m < 4; ++m) { const int sr = sr0 + ai * 128 + m * 16; const float gt = tb[ai * 128 + wr * 64 + m * 16 + fr] * YSCALE;
                u32x4 q;
                { const f32x4 v = (acc[ai][0][m][0] * (1.0f / WSCALE) + bb[0][0]) * gt; q.x = pk4_fp8(v[0], v[1], v[2], v[3]); }
                { const f32x4 v = (acc[ai][0][m][1] * (1.0f / WSCALE) + bb[0][1]) * gt; q.y = pk4_fp8(v[0], v[1], v[2], v[3]); }
                { const f32x4 v = (acc[ai][1][m][0] * (1.0f / WSCALE) + bb[1][0]) * gt; q.z = pk4_fp8(v[0], v[1], v[2], v[3]); }
                { const f32x4 v = (acc[ai][1][m][1] * (1.0f / WSCALE) + bb[1][1]) * gt; q.w = pk4_fp8(v[0], v[1], v[2], v[3]); }
                *(u32x4*)(Y + (size_t)(base + sr) * D + cl) = q; } }
    }
};

__device__ __forceinline__ void tr_item(const float* W, int N, const float* ks, bf16_t* WT, int ldk, int k0, int n0, int drow0, LAS unsigned* tile, int lane) {
    const int kq = lane >> 4, nq = lane & 15;
    f32x4 v[8][2];
#pragma unroll
    for (int i2 = 0; i2 < 8; ++i2)
#pragma unroll
        for (int s = 0; s < 2; ++s) v[i2][s] = __builtin_nontemporal_load((const f32x4*)(W + (size_t)(k0 + 8 * i2 + 2 * kq + s) * N + n0 + 4 * nq));
    if (ks) {
#pragma unroll
        for (int i2 = 0; i2 < 8; ++i2)
#pragma unroll
            for (int s = 0; s < 2; ++s) v[i2][s] = v[i2][s] * ks[k0 + 8 * i2 + 2 * kq + s];
    }
#pragma unroll
    for (int i2 = 0; i2 < 8; ++i2)
#pragma unroll
        for (int j = 0; j < 4; ++j) tile[(4 * nq + j) * 32 + ((i2 ^ (nq & 7)) * 4) + kq] = cvt_pk_bf16(v[i2][0][j], v[i2][1][j]);
    LDS_WAIT();
    const int nr = lane >> 3, kc = lane & 7;
#pragma unroll
    for (int ir = 0; ir < 8; ++ir) { const int n = 8 * ir + nr; const u32x4 o = *(const LAS u32x4*)(tile + n * 32 + ((kc ^ ((n >> 2) & 7)) * 4));
        *(u32x4*)(WT + (size_t)(drow0 + n) * ldk + k0 + 8 * kc) = o; }
    LDS_WAIT();
}
__device__ __forceinline__ void tr_item8(const float* W, int N, const float* ks, float mul, unsigned char* WT, int ldk, int k0, int n0, int drow0, LAS unsigned* tile, int lane) {
    const int kq = lane >> 4, nq = lane & 15;
#pragma unroll
    for (int h = 0; h < 2; ++h) {
        f32x4 v[4][4];
#pragma unroll
        for (int i2 = 0; i2 < 4; ++i2)
#pragma unroll
            for (int s = 0; s < 4; ++s) v[i2][s] = __builtin_nontemporal_load((const f32x4*)(W + (size_t)(k0 + 64 * h + 16 * i2 + 4 * kq + s) * N + n0 + 4 * nq));
#pragma unroll
        for (int i2 = 0; i2 < 4; ++i2)
#pragma unroll
            for (int s = 0; s < 4; ++s) v[i2][s] = v[i2][s] * (ks ? ks[k0 + 64 * h + 16 * i2 + 4 * kq + s] * mul : mul);
#pragma unroll
        for (int i2 = 0; i2 < 4; ++i2)
#pragma unroll
            for (int j = 0; j < 4; ++j) tile[(4 * nq + j) * 32 + (((4 * h + i2) ^ (nq & 7)) * 4) + kq] = pk4_fp8(v[i2][0][j], v[i2][1][j], v[i2][2][j], v[i2][3][j]);
    }
    LDS_WAIT();
    const int nr = lane >> 3, kc = lane & 7;
#pragma unroll
    for (int ir = 0; ir < 8; ++ir) { const int n = 8 * ir + nr; const u32x4 o = *(const LAS u32x4*)(tile + n * 32 + ((kc ^ ((n >> 2) & 7)) * 4));
        *(u32x4*)(WT + (size_t)(drow0 + n) * ldk + k0 + 16 * kc) = o; }
    LDS_WAIT();
}
__device__ __forceinline__ int map_glu(int n0, int half) { return (n0 < half) ? 256 * (n0 / 128) + (n0 % 128) : 256 * ((n0 - half) / 128) + 128 + ((n0 - half) % 128); }

__device__ __forceinline__ void p0_pre(const Frame& F) {
    PHASE_IDS();
    const float* x = in_ptr(0); const float* g1 = in_ptr(1); const float* w_in = in_ptr(2); const float* g2 = in_ptr(12); const float* w_r = in_ptr(13);
    unsigned char* ws = F.ws;
    LAS unsigned* tile = (LAS unsigned*)(F.lds + wave * 8192);
    const int gw = F.bx * NWAVES + wave, NGW = F.G * NWAVES;
#define P0_LOAD(v, row_) do { const f32x4* xr = (const f32x4*)(x + (size_t)(row_) * D) + lane; _Pragma("unroll") for (int j = 0; j < 8; ++j) v[j] = __builtin_nontemporal_load(xr + 64 * j); } while (0)
#define P0_ROW(v, row_) do { float s = 0.f; \
        _Pragma("unroll") for (int j = 0; j < 8; ++j) s += (v[j][0] * v[j][0] + v[j][1] * v[j][1]) + (v[j][2] * v[j][2] + v[j][3] * v[j][3]); \
        s = wave_sum(s); \
        if (lane == 0) ((float*)(ws + WS_RS1))[row_] = 1.0f / sqrtf(s * (1.0f / D) + EPS); \
        u32x2* o = (u32x2*)((bf16_t*)(ws + WS_XB) + (size_t)(row_) * D) + lane; \
        _Pragma("unroll") for (int j = 0; j < 8; ++j) { u32x2 w; w.x = cvt_pk_bf16(v[j][0], v[j][1]); w.y = cvt_pk_bf16(v[j][2], v[j][3]); o[64 * j] = w; } \
        unsigned* o8 = (unsigned*)(ws + WS_XB8 + (size_t)(row_) * D) + lane; \
        _Pragma("unroll") for (int j = 0; j < 8; ++j) o8[64 * j] = pk4_fp8(v[j][0] * XS, v[j][1] * XS, v[j][2] * XS, v[j][3] * XS); } while (0)
    if (NGW * 8 == T) {
        f32x4 va[8], vb[8];
        P0_LOAD(va, gw);
#pragma unroll
        for (int i = 0; i < 8; i += 2) {
            asm volatile("" ::: "memory"); P0_LOAD(vb, gw + (i + 1) * NGW); asm volatile("" ::: "memory"); P0_ROW(va, gw + i * NGW);
            asm volatile("" ::: "memory"); if (i + 2 < 8) P0_LOAD(va, gw + (i + 2) * NGW); asm volatile("" ::: "memory"); P0_ROW(vb, gw + (i + 1) * NGW);
        }
    } else {
        for (int row = gw; row < T; row += NGW) { f32x4 v[8]; P0_LOAD(v, row); P0_ROW(v, row); }
    }
#undef P0_LOAD
#undef P0_ROW
    for (int idx = (F.bx * NTHREADS + tid); idx < NE * D; idx += F.G * NTHREADS) {
        const int e = idx >> 11, k = idx & 2047; const float val = w_r[k * NE + e] * g2[k];
        const unsigned hi = f2bf(val); const unsigned lo = f2bf(val - bf2f(hi));
        ((bf16_t*)(ws + WS_WRT))[idx] = (bf16_t)hi; ((bf16_t*)(ws + WS_WRT))[NE * D + idx] = (bf16_t)lo;
    }
    constexpr int I_A = (D / 64) * (3072 / 64), I_B = (D / 128) * (4096 / 64);
    for (int r = gw; r < I_A + I_B; r += NGW) {
        if (r < I_A) { const int nb = 3072 / 64, kb = r / nb, n0 = (r % nb) * 64; const int dr = (n0 < 2048) ? map_glu(n0, 1024) : n0;
            tr_item(w_in, NIN, g1, (bf16_t*)(ws + WS_WIN), D, kb * 64, n0, dr, tile, lane); }
        else { const int q = r - I_A, kb = q >> 6, n0 = (q & 63) * 64;
            tr_item8(w_in + 3072, NIN, g1, WSCALE, ws + WS_WIN8, D, kb * 128, n0, map_glu(n0, 2048), tile, lane); }
    }
}
constexpr int Q_CO = (CC / 64) * (D / 64), Q_PO = Q_CO, Q_PW = 4 * 16, Q_O = (D / 64) * (D / 64);
constexpr int Q_W1E = (D / 128) * (4096 / 64), Q_W2E = (DE / 128) * (D / 64);
constexpr int Q_SMALL = Q_CO + Q_O;
__device__ __forceinline__ int q_small_map(int i) { return i < Q_CO ? i : i + Q_PO + Q_PW; }
constexpr int Q_TOTAL = Q_SMALL + NE * (Q_W1E + Q_W2E);
static_assert(Q_SMALL % 2 == 0, "queue chunking");
__device__ __forceinline__ void conv_item(unsigned char* ws, int r, LAS unsigned* tile, int lane) {
    if (r < Q_CO) { const int nb = D / 64, kb = r / nb, n0 = (r % nb) * 64; tr_item(in_ptr(7), D, nullptr, (bf16_t*)(ws + WS_WCO), CC, kb * 64, n0, n0, tile, lane); return; } r -= Q_CO;
    if (r < Q_PO) { const int nb = D / 64, kb = r / nb, n0 = (r % nb) * 64; tr_item(in_ptr(10), D, nullptr, (bf16_t*)(ws + WS_WPO), CC, kb * 64, n0, n0, tile, lane); return; } r -= Q_PO;
    if (r < Q_PW) { const int g = r >> 4, q = r & 15, k0 = (q >> 2) * 64, j0 = (q & 3) * 64;
        const float* pw = in_ptr(8) + (size_t)g * 65536; const float* ps = in_ptr(9) + g * 256; bf16_t* o = (bf16_t*)(ws + WS_WPW) + (size_t)g * 65536;
        const int jj = j0 + 4 * (lane & 15); const f32x4 sc = *(const f32x4*)(ps + jj);
#pragma unroll
        for (int i = 0; i < 16; ++i) { const int k = k0 + 4 * i + (lane >> 4); const f32x4 v = *(const f32x4*)(pw + k * 256 + jj) * sc; u32x2 w; w.x = cvt_pk_bf16(v[0], v[1]); w.y = cvt_pk_bf16(v[2], v[3]); *(u32x2*)(o + k * 256 + jj) = w; }
        return; } r -= Q_PW;
    if (r < Q_O) { const int nb = D / 64, kb = r / nb, n0 = (r % nb) * 64; tr_item(in_ptr(11), D, nullptr, (bf16_t*)(ws + WS_WO), D, kb * 64, n0, n0, tile, lane); return; } r -= Q_O;
    if (r < NE * Q_W1E) { const int e = r / Q_W1E, q = r % Q_W1E; const int nb = 4096 / 64, kb = q / nb, n0 = (q % nb) * 64;
        tr_item8(in_ptr(15) + (size_t)e * D * 4096, 4096, nullptr, WSCALE, ws + WS_W1 + (size_t)e * 4096 * D, D, kb * 128, n0, map_glu(n0, 2048), tile, lane); return; } r -= NE * Q_W1E;
    { const int e = r / Q_W2E, q = r % Q_W2E; const int nb = D / 64, kb = q / nb, n0 = (q % nb) * 64;
        tr_item8(in_ptr(17) + (size_t)e * DE * D, D, nullptr, WSCALE, ws + WS_W2 + (size_t)e * D * DE, DE, kb * 128, n0, n0, tile, lane); }
}
__device__ __forceinline__ void p0_pool_weights(const Frame& F) {
    PHASE_IDS();
    LAS unsigned* tile = (LAS unsigned*)(F.lds + wave * 8192);
    for (int r = F.bx * NWAVES + wave; r < Q_PO + Q_PW; r += F.G * NWAVES) conv_item(F.ws, Q_CO + r, tile, lane);
}
constexpr int QP_W1E = (D / 128) * (4096 / 128), QP_W2E = (DE / 128) * (D / 128);
constexpr int QC_SMALL = Q_SMALL / 2, QC_TOTAL = QC_SMALL + NE * (QP_W1E + QP_W2E);
struct QDesc { const float* W; unsigned char* WT; int N, ldk, k0, n0, drow0; };
__device__ __forceinline__ QDesc q_decode(unsigned char* ws, int r, const float* w1, const float* w2) {
    QDesc d;
    if (r < NE * QP_W1E) { const int e = r / QP_W1E, q = r % QP_W1E, kb = q >> 5, n0 = (q & 31) * 128;
        d.W = w1 + (size_t)e * D * 4096; d.WT = ws + WS_W1 + (size_t)e * 4096 * D; d.N = 4096; d.ldk = D; d.k0 = kb * 128; d.n0 = n0; d.drow0 = map_glu(n0, 2048); }
    else { r -= NE * QP_W1E; const int e = r / QP_W2E, q = r % QP_W2E, kb = q >> 4, n0 = (q & 15) * 128;
        d.W = w2 + (size_t)e * DE * D; d.WT = ws + WS_W2 + (size_t)e * D * DE; d.N = D; d.ldk = DE; d.k0 = kb * 128; d.n0 = n0; d.drow0 = n0; }
    return d;
}
__device__ __forceinline__ const float* q_base(const QDesc& d, int lane) { return d.W + (size_t)(d.k0 + 4 * (lane >> 5)) * d.N + d.n0 + 4 * (lane & 31); }
template <int E> __device__ __forceinline__ void q_load(f32x4 (&v)[8], const float* pb, int N) {
#pragma unroll
    for (int i = 0; i < 8; ++i) { const float* p = pb + (size_t)((16 * E + 8 * (i >> 2) + (i & 3)) * N);
        asm volatile("global_load_dwordx4 %0, %1, off nt" : "=v"(v[i]) : "v"(p) : "memory"); }
}
template <int N> __device__ __forceinline__ void q_wait(f32x4 (&v)[8]) {
    asm volatile("s_waitcnt vmcnt(%8)" : "+v"(v[0]), "+v"(v[1]), "+v"(v[2]), "+v"(v[3]), "+v"(v[4]), "+v"(v[5]), "+v"(v[6]), "+v"(v[7]) : "n"(N) : "memory");
}
template <int E> __device__ __forceinline__ void q_proc(const f32x4 (&v)[8], LAS unsigned* tile, int lane) {
    const int kq = lane >> 5, nq = lane & 31;
#pragma unroll
    for (int h = 0; h < 2; ++h) {
#pragma unroll
        for (int j = 0; j < 4; ++j) tile[(4 * nq + j) * 32 + ((E ^ (nq & 7)) * 4) + 2 * h + kq] = pk4_fp8(v[4 * h][j] * WSCALE, v[4 * h + 1][j] * WSCALE, v[4 * h + 2][j] * WSCALE, v[4 * h + 3][j] * WSCALE); }
}
__device__ __forceinline__ void q_readout(const QDesc& d, LAS unsigned* tile, int lane) {
    LDS_WAIT();
    const int nr = lane >> 3, kc = lane & 7;
#pragma unroll
    for (int ir = 0; ir < 16; ++ir) { const int n = 8 * ir + nr; const u32x4 o = *(const LAS u32x4*)(tile + n * 32 + ((kc ^ ((n >> 2) & 7)) * 4));
        __builtin_nontemporal_store(o, (u32x4*)(d.WT + (size_t)(d.drow0 + n) * d.ldk + d.k0 + 16 * kc)); }
    LDS_WAIT();
}
constexpr int QG_SMALL = QC_SMALL / 8, QG_TOTAL = QC_TOTAL / 8;
static_assert(QC_SMALL % 8 == 0 && QC_TOTAL % 8 == 0, "queue grouping");
__device__ __forceinline__ void conv_queue(const Frame& F) {
    PHASE_IDS();
    unsigned* qhead = (unsigned*)(F.ws + WS_CTL) + CW_QHEAD;
    LAS unsigned* tile = (LAS unsigned*)(F.lds + wave * 16384);
    volatile LAS int* slot = (volatile LAS int*)(F.lds + L_UNITS);
    int it = 0;
    if (tid == 0) slot[0] = (int)__hip_atomic_fetch_add(qhead, 1u, __ATOMIC_RELAXED, __HIP_MEMORY_SCOPE_AGENT);
    __syncthreads();
    int g = __builtin_amdgcn_readfirstlane(slot[0]);
    while (g < QG_SMALL) {
        if (tid == 0) slot[(it + 1) & 1] = (int)__hip_atomic_fetch_add(qhead, 1u, __ATOMIC_RELAXED, __HIP_MEMORY_SCOPE_AGENT);
        const int c = 8 * g + wave; conv_item(F.ws, q_small_map(2 * c), tile, lane); conv_item(F.ws, q_small_map(2 * c + 1), tile, lane);
        __syncthreads();
        g = __builtin_amdgcn_readfirstlane(slot[(it + 1) & 1]); ++it;
    }
    if (g >= QG_TOTAL) return;
    const float* w1 = in_ptr(15); const float* w2 = in_ptr(17);
    if (tid == 0) slot[(it + 1) & 1] = (int)__hip_atomic_fetch_add(qhead, 1u, __ATOMIC_RELAXED, __HIP_MEMORY_SCOPE_AGENT);
    __syncthreads();
    int gnext = __builtin_amdgcn_readfirstlane(slot[(it + 1) & 1]); ++it;
    QDesc d = q_decode(F.ws, 8 * g + wave - QC_SMALL, w1, w2);
    f32x4 v0[8], v1[8], v2[8], v3[8];
    unsigned pend2 = 0u;
    const float* pd = q_base(d, lane);
    q_load<0>(v0, pd, d.N); q_load<1>(v1, pd, d.N); q_load<2>(v2, pd, d.N);
#define Q_FENCE() do { asm volatile("" ::: "memory"); __builtin_amdgcn_sched_barrier(0); } while (0)
    for (;;) {
        const int nr = (gnext < QG_TOTAL) ? 8 * gnext + wave : -1;
        if (nr >= 0) { if (tid == 0) asm volatile("global_atomic_add %0, %1, %2, %3 sc0" : "=v"(pend2) : "v"(0), "v"(1), "s"(qhead) : "memory"); }
        const QDesc dn = (nr >= 0) ? q_decode(F.ws, nr - QC_SMALL, w1, w2) : d;
        const float* pn = q_base(dn, lane);
        Q_FENCE(); q_load<3>(v3, pd, d.N);  Q_FENCE(); q_wait<24>(v0); q_proc<0>(v0, tile, lane);
        Q_FENCE(); q_load<4>(v0, pd, d.N);  Q_FENCE(); q_wait<24>(v1); q_proc<1>(v1, tile, lane);
        Q_FENCE(); q_load<5>(v1, pd, d.N);  Q_FENCE(); q_wait<24>(v2); q_proc<2>(v2, tile, lane);
        Q_FENCE(); q_load<6>(v2, pd, d.N);  Q_FENCE(); q_wait<24>(v3); q_proc<3>(v3, tile, lane);
        Q_FENCE(); q_load<7>(v3, pd, d.N);  Q_FENCE(); q_wait<24>(v0); q_proc<4>(v0, tile, lane);
        Q_FENCE(); q_load<0>(v0, pn, dn.N); Q_FENCE(); q_wait<24>(v1); q_proc<5>(v1, tile, lane);
        Q_FENCE(); q_load<1>(v1, pn, dn.N); Q_FENCE(); q_wait<24>(v2); q_proc<6>(v2, tile, lane);
        Q_FENCE(); q_load<2>(v2, pn, dn.N); Q_FENCE(); q_wait<24>(v3); q_proc<7>(v3, tile, lane);
        Q_FENCE(); q_readout(d, tile, lane); Q_FENCE();
        if (nr < 0) break;
        if (tid == 0) { asm volatile("s_waitcnt vmcnt(24)" : "+v"(pend2) :: "memory"); slot[(it + 1) & 1] = (int)pend2; }
        LDS_WAIT(); Q_FENCE(); __builtin_amdgcn_s_barrier(); Q_FENCE();
        gnext = __builtin_amdgcn_readfirstlane(slot[(it + 1) & 1]); ++it;
        d = dn; pd = pn;
    }
    asm volatile("s_waitcnt vmcnt(0)" ::: "memory");
#undef Q_FENCE
}

template <int W> __device__ __forceinline__ void pool_item(const unsigned (&pr)[31], bf16_t* DP, int t0, int s0, int c0) {
#pragma unroll
    for (int o = 0; o < 16; ++o) { float a0 = 0.f, a1 = 0.f;
#pragma unroll
        for (int j = 0; j < W; ++j) { a0 += bflo(pr[15 + o - j]); a1 += bfhi(pr[15 + o - j]); }
        const int pos = s0 + o + 1; const float inv = 1.0f / (float)(pos < W ? pos : W);
        *(unsigned*)(DP + (size_t)(t0 + o) * CC + c0) = cvt_pk_bf16(a0 * inv - bflo(pr[15 + o]), a1 * inv - bfhi(pr[15 + o])); }
}
__device__ __forceinline__ void p2_conv_pool(const Frame& F, const Args& a) {
    PHASE_IDS();
    const float* conv_w = in_ptr(3); const float* conv_b = in_ptr(4); const float* ln_g = in_ptr(5); const float* ln_b = in_ptr(6);
    const bf16_t* U = (const bf16_t*)(F.ws + WS_U); const bf16_t* P = (const bf16_t*)(F.ws + WS_P);
    bf16_t* AC = (bf16_t*)(F.ws + WS_AC); bf16_t* DP = (bf16_t*)(F.ws + WS_DP);
    const int c0 = 2 * tid;
    f32x2 wv[31];
#pragma unroll
    for (int j = 0; j < 31; ++j) wv[j] = *(const f32x2*)(conv_w + j * CC + c0);
    const f32x2 cb = *(const f32x2*)(conv_b + c0), lg = *(const f32x2*)(ln_g + c0), lb = *(const f32x2*)(ln_b + c0);
    const int gi = wave >> 1;
    int par = 0;
    unsigned pr[31], ur[46], ur2[46];
#define P2_LOADP(PR, it) do { const int t0_ = (it) * 16, s0_ = t0_ & (SEQ - 1); \
        _Pragma("unroll") for (int r = 0; r < 31; ++r) { PR[r] = 0u; if (s0_ - 15 + r >= 0) PR[r] = *(const unsigned*)(P + (size_t)(t0_ - 15 + r) * CC + c0); } } while (0)
#define P2_LOADU(UR, it) do { const int t0_ = (it) * 16, s0_ = t0_ & (SEQ - 1); \
        _Pragma("unroll") for (int r = 0; r < 46; ++r) { UR[r] = 0u; if (s0_ - 30 + r >= 0) UR[r] = *(const unsigned*)(U + (size_t)(t0_ - 30 + r) * CC + c0); } } while (0)
    if (F.bx < T / 16) P2_LOADU(ur, F.bx);
    for (int item = F.bx; item < T / 16; item += F.G, par ^= 1) {
        LAS float* red = (LAS float*)(F.lds + par * 65536);
        LAS float* tot = (LAS float*)(F.lds + L_TBL + par * 256);
        const int t0 = item * 16, s0 = t0 & (SEQ - 1);
        const int nitem = (item + F.G < T / 16) ? item + F.G : item;
        P2_LOADP(pr, item); P2_LOADU(ur2, nitem);
        asm volatile("" ::: "memory");
        if (gi == 0) pool_item<2>(pr, DP, t0, s0, c0); else if (gi == 1) pool_item<4>(pr, DP, t0, s0, c0); else if (gi == 2) pool_item<8>(pr, DP, t0, s0, c0); else pool_item<16>(pr, DP, t0, s0, c0);
        f32x2 av[16];
#pragma unroll
        for (int o = 0; o < 16; ++o) av[o] = cb;
#pragma unroll
        for (int r = 0; r < 46; ++r) {
            const f32x2 uv = (f32x2){bflo(ur[r]), bfhi(ur[r])};
#pragma unroll
            for (int o = 0; o < 16; ++o) { const int j = r - o; if (j >= 0 && j <= 30) av[o] = __builtin_elementwise_fma(wv[j], uv, av[o]); }
        }
#pragma unroll
        for (int o = 0; o < 16; ++o) { red[o * 512 + tid] = av[o][0] + av[o][1]; red[(16 + o) * 512 + tid] = av[o][0] * av[o][0] + av[o][1] * av[o][1]; }
        __syncthreads();
#pragma unroll
        for (int q = 0; q < 4; ++q) { const int row = wave * 4 + q; float s = 0.f;
#pragma unroll
            for (int i = 0; i < 8; ++i) s += red[row * 512 + lane + 64 * i];
            s = wave_sum(s); if (lane == 0) tot[row] = s; }
        __syncthreads();
#pragma unroll
        for (int o = 0; o < 16; ++o) { const float mean = tot[o] * (1.0f / CC), var = tot[16 + o] * (1.0f / CC) - mean * mean; const float rstd = 1.0f / sqrtf(fmaxf(var, 0.f) + EPS);
            const float y0 = (av[o][0] - mean) * rstd * lg[0] + lb[0], y1 = (av[o][1] - mean) * rstd * lg[1] + lb[1];
            *(unsigned*)(AC + (size_t)(t0 + o) * CC + c0) = cvt_pk_bf16(y0 * sigmoidf_(y0), y1 * sigmoidf_(y1)); }
        asm volatile("" ::: "memory");
#pragma unroll
        for (int r = 0; r < 46; ++r) ur[r] = ur2[r];
    }
#undef P2_LOADP
#undef P2_LOADU
    __syncthreads();
}

__device__ __forceinline__ void p6_router(const Frame& F, const Args& a) {
    PHASE_IDS();
    const float* b_r = in_ptr(14);
    const bf16_t* H = (const bf16_t*)(F.ws + WS_H); const float* SSQP = (const float*)(F.ws + WS_SSQP);
    const bf16_t* WH = (const bf16_t*)(F.ws + WS_WRT); const bf16_t* WL = WH + NE * D;
    int* ltok = (int*)(F.ws + WS_LTOK); float* lgate = (float*)(F.ws + WS_LGATE); float* lrs = (float*)(F.ws + WS_LRS); int* slotref = (int*)(F.ws + WS_SLOTREF);
    unsigned* cnt = (unsigned*)(F.ws + WS_CTL) + CW_CNT;
    const int fr = lane & 15, fq = lane >> 4;
    const int grp = wave & 3, kh = wave >> 2;
    LAS float* lg = (LAS float*)(F.lds + grp * 4096);
    LAS float* part = (LAS float*)(F.lds + 16384 + grp * 2048);
    LAS unsigned* lcnt = (LAS unsigned*)(F.lds + 32768);
    LAS unsigned* gbase = (LAS unsigned*)(F.lds + 32768 + 128);
    for (int item = F.bx; item < T / 64; item += F.G) {
        const int t0 = item * 64 + grp * 16;
        const bf16_t* hrow = H + (size_t)(t0 + fr) * D + 8 * fq + kh * 1024;
        const bf16_t* wh = WH + (size_t)fr * D + 8 * fq + kh * 1024; const bf16_t* wl = WL + (size_t)fr * D + 8 * fq + kh * 1024;
        f32x4 acc0 = (f32x4){0.f, 0.f, 0.f, 0.f}, acc1 = acc0;
        bf16x8 hb[4][2], ah[4][2], bh[4][2], al[4][2], bl[4][2];
        const bf16_t* pA = wh; const bf16_t* pB = wh + 16 * D; const bf16_t* pC = wl; const bf16_t* pD = wl + 16 * D; const bf16_t* pH = hrow;
        asm volatile("" : "+v"(pA), "+v"(pB), "+v"(pC), "+v"(pD), "+v"(pH));
#define R_LOAD(buf, s0) do { _Pragma("unroll") for (int i = 0; i < 2; ++i) { const int o = 32 * ((s0) + i); hb[buf][i] = *(const bf16x8*)(pH + o); ah[buf][i] = *(const bf16x8*)(pA + o); bh[buf][i] = *(const bf16x8*)(pB + o); \
            al[buf][i] = *(const bf16x8*)(pC + o); bl[buf][i] = *(const bf16x8*)(pD + o); } } while (0)
#define R_FENCE() do { asm volatile("" ::: "memory"); __builtin_amdgcn_sched_barrier(0); } while (0)
        R_LOAD(0, 0); R_LOAD(1, 2); R_LOAD(2, 4); R_FENCE();
#pragma unroll
        for (int b = 0; b < 16; ++b) {
            if (b + 3 < 16) R_LOAD((b + 3) & 3, 2 * (b + 3));
            R_FENCE();
#pragma unroll
            for (int i = 0; i < 2; ++i) {
                acc0 = __builtin_amdgcn_mfma_f32_16x16x32_bf16(ah[b & 3][i], hb[b & 3][i], acc0, 0, 0, 0); acc0 = __builtin_amdgcn_mfma_f32_16x16x32_bf16(al[b & 3][i], hb[b & 3][i], acc0, 0, 0, 0);
                acc1 = __builtin_amdgcn_mfma_f32_16x16x32_bf16(bh[b & 3][i], hb[b & 3][i], acc1, 0, 0, 0); acc1 = __builtin_amdgcn_mfma_f32_16x16x32_bf16(bl[b & 3][i], hb[b & 3][i], acc1, 0, 0, 0);
            }
            R_FENCE();
        }
#undef R_LOAD
#undef R_FENCE
        if (kh == 1) { *(LAS f32x4*)(part + lane * 8) = acc0; *(LAS f32x4*)(part + lane * 8 + 4) = acc1; }
        if (tid < NE) lcnt[tid] = 0u;
        __syncthreads();
        float p[4] = {0.f, 0.f, 0.f, 0.f}; int ti[4] = {0, 0, 0, 0}; unsigned lpos[4] = {0u, 0u, 0u, 0u}; float inv = 0.f, rs_tok = 0.f;
        if (kh == 0) {
        acc0 = acc0 + *(const LAS f32x4*)(part + lane * 8); acc1 = acc1 + *(const LAS f32x4*)(part + lane * 8 + 4);
        float ss = 0.f;
#pragma unroll
        for (int i = 0; i < 8; ++i) { const f32x4 pp = *(const f32x4*)(SSQP + (size_t)(t0 + fr) * 32 + 4 * i); ss += (pp[0] + pp[1]) + (pp[2] + pp[3]); }
        const float rs = 1.0f / sqrtf(ss * (1.0f / D) + EPS);
#pragma unroll
        for (int j = 0; j < 4; ++j) { lg[fr * 33 + 4 * fq + j] = acc0[j] * rs + b_r[4 * fq + j]; lg[fr * 33 + 16 + 4 * fq + j] = acc1[j] * rs + b_r[16 + 4 * fq + j]; }
        LDS_WAIT(); __builtin_amdgcn_wave_barrier();
        if (lane < 16) {
            float v[32];
#pragma unroll
            for (int e = 0; e < 32; ++e) v[e] = lg[lane * 33 + e];
            float tv[4];
#pragma unroll
            for (int k = 0; k < 4; ++k) { float best = -3.0e38f; int bi = 0;
#pragma unroll
                for (int e = 0; e < 32; ++e) if (v[e] > best) { best = v[e]; bi = e; }
                tv[k] = best; ti[k] = bi;
#pragma unroll
                for (int e = 0; e < 32; ++e) v[e] = (e == bi) ? -3.0e38f : v[e]; }
            float sum = 0.f;
#pragma unroll
            for (int k = 0; k < 4; ++k) { p[k] = __expf(tv[k] - tv[0]); sum += p[k]; }
            inv = 1.0f / sum; rs_tok = rs;
#pragma unroll
            for (int k = 0; k < 4; ++k) lpos[k] = __hip_atomic_fetch_add(lcnt + ti[k], 1u, __ATOMIC_RELAXED, __HIP_MEMORY_SCOPE_WORKGROUP);
        }
        }
        __syncthreads();
        if (tid < NE) { const unsigned c = lcnt[tid]; gbase[tid] = c ? __hip_atomic_fetch_add(cnt + 64 * tid, c, __ATOMIC_RELAXED, __HIP_MEMORY_SCOPE_AGENT) : 0u; }
        __syncthreads();
        if (kh == 0 && lane < 16) { const int tok = t0 + lane;
#pragma unroll
            for (int k = 0; k < 4; ++k) { const int e = ti[k]; const unsigned pos = gbase[e] + lpos[k];
                ltok[e * LCAP + pos] = tok; lgate[e * LCAP + pos] = p[k] * inv; lrs[e * LCAP + pos] = rs_tok; slotref[tok * 4 + k] = (e << 16) | (int)pos; }
        }
        __syncthreads();
    }
}

__device__ __forceinline__ void moe_prepare(const Frame& F) {
    PHASE_IDS();
    unsigned* cnt = (unsigned*)(F.ws + WS_CTL) + CW_CNT;
    LAS int* lc = (LAS int*)(F.lds + L_CNT); LAS int* lb = (LAS int*)(F.lds + L_BASE); LAS int* ln = (LAS int*)(F.lds + L_NRT);
    __syncthreads();
    if (tid < NE) { const int c = (int)__hip_atomic_load(cnt + 64 * tid, __ATOMIC_RELAXED, __HIP_MEMORY_SCOPE_AGENT); lc[tid] = c; ln[tid] = (c + 255) >> 8; }
    __syncthreads();
    if (tid < NE) { int b = 0; for (int e = 0; e < NE; ++e) { const int v = ln[e]; b += (e < tid) ? v : 0; } lb[tid] = b * 256; }
    __syncthreads();
}
template <int NCB, int CPB  , bool GLOBAL> __device__ __forceinline__ void moe_build_units(const Frame& F) {
    PHASE_IDS();
    LAS int* ln = (LAS int*)(F.lds + L_NRT); LAS int* lu = (LAS int*)(F.lds + L_UNITS); LAS int* lnu = (LAS int*)(F.lds + L_NU);
    constexpr int EM = 8 / NCB;
    if (GLOBAL && F.G == 256) {
        const int j = (F.bx % 8) * 32 + F.bx / 8;
        int code = 0; bool has = false;
        if (tid < NE * NCB) { const int e = tid / NCB, cb = tid % NCB; int pre = 0;
            for (int e2 = 0; e2 < NE; ++e2) { const int v = ln[e2]; pre += (e2 < e) ? v : 0; }
            const int nrt = ln[e], n = nrt * CPB, pos = (pre * NCB + cb * nrt) * CPB, q = (j - pos) & 255;
            has = q < n; code = (e << 16) | ((q / CPB) << 8) | (cb * CPB + q % CPB); }
        const unsigned long long m = __ballot(has);
        if (tid == 0) lnu[1] = __popcll(m);
        __syncthreads();
        if (tid < NE * NCB) { const int off = (wave == 1) ? lnu[1] : 0;
            if (has) lu[off + __popcll(m & ((1ull << lane) - 1ull))] = code;
            if (tid == 64) lnu[0] = off + __popcll(m); }
        __syncthreads();
        return;
    }
    if (tid == 0) {
        const int NS = (F.G % 8 == 0 && !GLOBAL) ? 8 : 1; const int x = F.bx % NS;
        const int j = GLOBAL ? ((F.G % 8 == 0) ? (F.bx % 8) * (F.G / 8) + F.bx / 8 : F.bx) : F.bx / NS, nj = F.G / NS;
        int p = 0, nu = 0;
        for (int e = 0; e < NE; ++e) {
            for (int cb = 0; cb < NCB; ++cb) {
                if (NS == 8) { if ((e % EM) != (x % EM)) continue; if (cb != (((e / EM) + (x / EM)) % NCB)) continue; }
                const int n = ln[e] * CPB;
                int q = (j - (p % nj) + nj) % nj;
                for (; q < n; q += nj) { const int rt = q / CPB, c4 = q % CPB; if (nu < 256) lu[nu++] = (e << 16) | (rt << 8) | (cb * CPB + c4); }
                p += n;
            }
        }
        lnu[0] = nu;
    }
    __syncthreads();
}

__device__ __forceinline__ void p9_combine(const Frame& F, const Args& a) {
    PHASE_IDS();
    const float* gf = in_ptr(19); const bf16_t* H = (const bf16_t*)(F.ws + WS_H); const unsigned char* Y = (const unsigned char*)(F.ws + WS_Y); const int* slotref = (const int*)(F.ws + WS_SLOTREF);
    const LAS int* lb = (const LAS int*)(F.lds + L_BASE);
    const int gw = F.bx * NWAVES + wave, NGW = F.G * NWAVES;
    float* out = out_ptr();
    f32x4 gv[8];
#pragma unroll
    for (int q = 0; q < 8; ++q) gv[q] = ((const f32x4*)gf)[lane + 64 * q];
#define P9_ISSUE(hb, yb, tok_, sr_) do { _Pragma("unroll") for (int q = 0; q < 8; ++q) hb[q] = ((const u32x2*)(H + (size_t)(tok_) * D))[lane + 64 * q]; \
        _Pragma("unroll") for (int k = 0; k < 4; ++k) { const int sr = (sr_)[k]; const int slot = lb[sr >> 16] + (sr & 0xffff); const unsigned* yr = (const unsigned*)(Y + (size_t)slot * D) + lane; \
            _Pragma("unroll") for (int q = 0; q < 8; ++q) yb[k][q] = yr[64 * q]; } } while (0)
#define P9_FIN(hb, yb, tok_) do { f32x4 v[8]; \
        _Pragma("unroll") for (int q = 0; q < 8; ++q) v[q] = (f32x4){bflo(hb[q].x), bfhi(hb[q].x), bflo(hb[q].y), bfhi(hb[q].y)}; \
        _Pragma("unroll") for (int k = 0; k < 4; ++k) _Pragma("unroll") for (int q = 0; q < 8; ++q) { const unsigned w = yb[k][q]; const f32x2 lo = __builtin_amdgcn_cvt_pk_f32_fp8((int)w, false), hi = __builtin_amdgcn_cvt_pk_f32_fp8((int)w, true); \
            v[q][0] += lo[0] * (1.0f / YSCALE); v[q][1] += lo[1] * (1.0f / YSCALE); v[q][2] += hi[0] * (1.0f / YSCALE); v[q][3] += hi[1] * (1.0f / YSCALE); } \
        float s = 0.f; \
        _Pragma("unroll") for (int q = 0; q < 8; ++q) s += (v[q][0] * v[q][0] + v[q][1] * v[q][1]) + (v[q][2] * v[q][2] + v[q][3] * v[q][3]); \
        s = wave_sum(s); const float rs = 1.0f / sqrtf(s * (1.0f / D) + EPS); \
        _Pragma("unroll") for (int q = 0; q < 8; ++q) __builtin_nontemporal_store(v[q] * rs * gv[q], (f32x4*)(out + (size_t)(tok_) * D) + lane + 64 * q); } while (0)
#define P9_FENCE() asm volatile("" ::: "memory")
    if (NGW * 8 == T) {
        i32x4 srs[8];
#pragma unroll
        for (int i = 0; i < 8; ++i) srs[i] = *(const i32x4*)(slotref + (gw + i * NGW) * 4);
        u32x2 hA[8], hB[8]; unsigned yA[4][8], yB[4][8];
        P9_ISSUE(hA, yA, gw, srs[0]);
#pragma unroll
        for (int i = 0; i < 8; i += 2) {
            P9_FENCE(); P9_ISSUE(hB, yB, gw + (i + 1) * NGW, srs[i + 1]); P9_FENCE(); P9_FIN(hA, yA, gw + i * NGW);
            P9_FENCE(); if (i + 2 < 8) P9_ISSUE(hA, yA, gw + (i + 2) * NGW, srs[i + 2]); P9_FENCE(); P9_FIN(hB, yB, gw + (i + 1) * NGW);
        }
        return;
    }
#undef P9_ISSUE
#undef P9_FIN
#undef P9_FENCE
    for (int tok = gw; tok < T; tok += NGW) {
        f32x4 v[8];
#pragma unroll
        for (int q = 0; q < 8; ++q) { const u32x2 w = ((const u32x2*)(H + (size_t)tok * D))[lane + 64 * q]; v[q] = (f32x4){bflo(w.x), bfhi(w.x), bflo(w.y), bfhi(w.y)}; }
        const i32x4 sr4 = *(const i32x4*)(slotref + tok * 4);
#pragma unroll
        for (int k = 0; k < 4; ++k) { const int sr = sr4[k]; const int slot = lb[sr >> 16] + (sr & 0xffff);
            const unsigned* yr = (const unsigned*)(Y + (size_t)slot * D) + lane;
#pragma unroll
            for (int q = 0; q < 8; ++q) { const unsigned w = yr[64 * q]; const f32x2 lo = __builtin_amdgcn_cvt_pk_f32_fp8((int)w, false), hi = __builtin_amdgcn_cvt_pk_f32_fp8((int)w, true);
                v[q][0] += lo[0] * (1.0f / YSCALE); v[q][1] += lo[1] * (1.0f / YSCALE); v[q][2] += hi[0] * (1.0f / YSCALE); v[q][3] += hi[1] * (1.0f / YSCALE); } }
        float s = 0.f;
#pragma unroll
        for (int q = 0; q < 8; ++q) s += (v[q][0] * v[q][0] + v[q][1] * v[q][1]) + (v[q][2] * v[q][2] + v[q][3] * v[q][3]);
        s = wave_sum(s); const float rs = 1.0f / sqrtf(s * (1.0f / D) + EPS);
#pragma unroll
        for (int q = 0; q < 8; ++q) __builtin_nontemporal_store(v[q] * rs * gv[q], (f32x4*)(out + (size_t)tok * D) + lane + 64 * q);
    }
}

constexpr int NPH = 10;
__global__ void __launch_bounds__(NTHREADS, 2) fwd(Args args) {
    extern __shared__ __attribute__((aligned(16))) unsigned char lds_raw[];
    Frame F; F.lds = (LAS unsigned char*)lds_raw; F.ws = args.ws;
    F.G = gridDim.x; F.bx = blockIdx.x;
    { const int t0 = tid_opaque(); for (int u = t0; u < (LDS_BYTES - STAGE_BYTES) / 4; u += NTHREADS) ((LAS unsigned*)(F.lds + STAGE_BYTES))[u] = 0u; }
    __syncthreads();
    unsigned* ctl = (unsigned*)(args.ws + WS_CTL);
    XcdBarrier bar; bar.bar = ctl + CW_BAR; bar.x = 0; bar.st = nullptr;
    if (N_LAUNCHES == 1) bar = xcd_barrier_post(ctl + CW_BAR, (volatile LAS unsigned*)(F.lds + L_MISC) + 8);
    const int lo = args.ph_lo, hi = args.ph_hi;
#define IN(k) (lo <= (k) && (k) < hi)
#define SEAM(k) do { if (IN(k) && IN((k) + 1)) xcd_barrier(bar); } while (0)
    unsigned char* ws = args.ws;

    if (IN(0)) { p0_pre(F); p0_pool_weights(F); } SEAM(0);

    if (IN(1)) {
        const bool split = (F.G == 256);
        const int ggemm = split ? 160 : F.G;
        if (F.bx < ggemm) {
            { DenseSched S; S.A = (const char*)(ws + WS_XB); S.B = (const char*)(ws + WS_WIN); S.lda = D; S.ldb = D; S.G = ggemm; S.c = F.bx; S.to.init(T, 3072);
              EpiWin E{(bf16_t*)(ws + WS_U), (bf16_t*)(ws + WS_P), (const float*)(ws + WS_RS1), F.lds};
              gemm_phase<EpiWin, DenseSched, false, false>(F.lds, D * 2, D * 2, S, E); }
            { DenseSched8 S; S.A = (const char*)(ws + WS_XB8); S.B = (const char*)(ws + WS_WIN8); S.lda = D; S.ldb = D; S.G = ggemm; S.c = ggemm - 1 - F.bx; S.to.init(T, 4096);
              EpiGate E{(bf16_t*)(ws + WS_G), (const float*)(ws + WS_RS1), F.lds};
              gemm_phase<EpiGate, DenseSched8, false, true>(F.lds, D, D, S, E); }
            if (split && F.bx >= 8 && F.bx < 40) {
                PoolSched S2; S2.A = (const char*)(ws + WS_WPO); S2.B = (const char*)(ws + WS_WPW); S2.G = 32; S2.c = F.bx - 8;
                EpiPool E2{(bf16_t*)(ws + WS_YP)};
                gemm_phase<EpiPool, PoolSched, false, false>(F.lds, 256 * 2, 256 * 2, S2, E2);
            }
        }
        conv_queue(F);
    } SEAM(1);


    if (IN(2)) {
        if (F.G != 256) { PoolSched S; S.A = (const char*)(ws + WS_WPO); S.B = (const char*)(ws + WS_WPW); S.G = F.G; S.c = F.bx;
          EpiPool E{(bf16_t*)(ws + WS_YP)};
          gemm_phase<EpiPool, PoolSched, false, false>(F.lds, 256 * 2, 256 * 2, S, E); }
        __syncthreads();
        p2_conv_pool(F, args);
    } SEAM(2);

    if (IN(4)) {
        MergeSched S; S.A0 = (const char*)(ws + WS_AC); S.A1 = (const char*)(ws + WS_DP); S.B0 = (const char*)(ws + WS_WCO); S.B1 = (const char*)(ws + WS_YP); S.G = F.G; S.c = F.bx; S.to.init(T, D);
        EpiMerge E{(bf16_t*)(ws + WS_MG), (const bf16_t*)(ws + WS_G)};
        gemm_phase<EpiMerge, MergeSched, false, false>(F.lds, CC * 2, CC * 2, S, E);
    } SEAM(4);

    if (IN(5)) {
        DenseSched S; S.A = (const char*)(ws + WS_MG); S.B = (const char*)(ws + WS_WO); S.lda = D; S.ldb = D; S.G = F.G; S.c = F.bx; S.to.init(T, D);
        EpiWo E{(const bf16_t*)(ws + WS_XB), (bf16_t*)(ws + WS_H), (unsigned char*)(ws + WS_HB), (float*)(ws + WS_SSQP), in_ptr(12)};
        gemm_phase<EpiWo, DenseSched, false, false>(F.lds, D * 2, D * 2, S, E);
    } SEAM(5);

    if (IN(6)) { p6_router(F, args); } SEAM(6);

    if (IN(7)) {
        moe_prepare(F); moe_build_units<4, 4, true>(F);
        MoeSched S; S.lds = F.lds; S.A = (const char*)(ws + WS_HB); S.B = (const char*)(ws + WS_W1); S.ltok = (const int*)(ws + WS_LTOK); S.gather = 1; S.nrows_w = 4096;
        EpiMoe1 E{(unsigned char*)(ws + WS_ACT), in_ptr(16), (const float*)(ws + WS_LRS), F.lds};
        gemm_phase<EpiMoe1, MoeSched, true, true>(F.lds, D, D, S, E);
    } SEAM(7);

    if (IN(8)) {
        if (!IN(7)) moe_prepare(F);
        moe_build_units<4, 2, true>(F);
        MoeSched S; S.lds = F.lds; S.A = (const char*)(ws + WS_ACT); S.B = (const char*)(ws + WS_W2); S.ltok = nullptr; S.gather = 0; S.nrows_w = 2048;
        EpiMoe2 E{(unsigned char*)(ws + WS_Y), in_ptr(18), (const float*)(ws + WS_LGATE), F.lds};
        gemm_phase<EpiMoe2, MoeSched, false, true>(F.lds, DE, DE, S, E);
    } SEAM(8);

    if (IN(9)) { if (!IN(7)) moe_prepare(F); p9_combine(F, args); }
#undef IN
#undef SEAM
}

extern "C" void kernel_launch(void* const* d_in, const int* in_sizes, int n_in, void* d_out, int out_size, void* d_ws, size_t ws_size, hipStream_t stream) {
    static int grid = 0;
    if (grid == 0) {
        if (n_in != 20 || in_sizes[0] != T * D || out_size != T * D || ws_size < WS_END) { fprintf(stderr, "kernel_launch: unexpected shapes (n_in %d, in0 %d, out %d, ws %zu)\n", n_in, n_in > 0 ? in_sizes[0] : -1, out_size, ws_size); grid = -1; return; }
        int dev = 0, cus = 0, per_cu = 0;
        if (hipGetDevice(&dev) != hipSuccess || hipDeviceGetAttribute(&cus, hipDeviceAttributeMultiprocessorCount, dev) != hipSuccess) { grid = -1; return; }
        if (hipFuncSetAttribute((const void*)fwd, hipFuncAttributeMaxDynamicSharedMemorySize, LDS_BYTES) != hipSuccess) { fprintf(stderr, "kernel_launch: hipFuncSetAttribute failed\n"); grid = -1; return; }
        if (hipOccupancyMaxActiveBlocksPerMultiprocessor(&per_cu, (const void*)fwd, NTHREADS, LDS_BYTES) != hipSuccess || per_cu < 1) fprintf(stderr, "kernel_launch: occupancy query says %d\n", per_cu);
        (void)hipGetLastError();
        grid = cus;
    }
    if (grid < 0) return;
    (void)hipMemsetAsync((char*)d_ws + WS_CTL, 0, CTL_ZERO_BYTES, stream);
    Args a{};
    for (int i = 0; i < 20; ++i) a.in[i] = (const float*)d_in[i];
    a.out = (float*)d_out; a.ws = (unsigned char*)d_ws; a.pad = 0;
    if (N_LAUNCHES == 1) { a.ph_lo = 0; a.ph_hi = NPH; a.li = 0; hipLaunchKernelGGL(fwd, dim3(grid), dim3(NTHREADS), LDS_BYTES, stream, a); }
    else for (int p = 0; p < NPH; ++p) { a.ph_lo = p; a.ph_hi = p + 1; a.li = p; hipLaunchKernelGGL(fwd, dim3(grid), dim3(NTHREADS), LDS_BYTES, stream, a); }
}
```

```cpp
#include <hip/hip_runtime.h>
#include <cstdio>
#include <cstdint>

#ifndef N_LAUNCHES
#define N_LAUNCHES 1
#endif

#define LAS __attribute__((address_space(3)))
#define GAS __attribute__((address_space(1)))
typedef unsigned short bf16_t;
typedef short bf16x8 __attribute__((ext_vector_type(8)));
typedef float f32x4 __attribute__((ext_vector_type(4)));
typedef float f32x2 __attribute__((ext_vector_type(2)));
typedef unsigned u32x4 __attribute__((ext_vector_type(4)));
typedef unsigned u32x2 __attribute__((ext_vector_type(2)));
typedef int i32x8 __attribute__((ext_vector_type(8)));
typedef int i32x4 __attribute__((ext_vector_type(4)));

constexpr int T = 16384, SEQ = 4096, D = 2048, CC = 1024, NIN = 7168, NE = 32, DE = 2048;
constexpr float EPS = 1e-5f;
constexpr float YSCALE = 16.0f;
constexpr float XS = 8.0f;
constexpr float WSCALE = 32.0f;
constexpr int LCAP = 16384;
constexpr int MAXSLOT = 73728;

constexpr size_t MiB = 1u << 20;
constexpr size_t WS_CTL = 0, CTL_ZERO_BYTES = 1 * MiB;
constexpr size_t WS_RS1 = 1 * MiB;
constexpr size_t WS_SSQP = 2 * MiB;
constexpr size_t WS_WRT = 4 * MiB;
constexpr size_t WS_ONES = 4 * MiB + 512 * 1024;
constexpr size_t WS_SLOTREF = 5 * MiB;
constexpr size_t WS_LTOK = 6 * MiB;
constexpr size_t WS_LGATE = 8 * MiB;
constexpr size_t WS_LRS = 10 * MiB;
constexpr size_t WS_WPW = 12 * MiB;
constexpr size_t WS_WCO = 13 * MiB;
constexpr size_t WS_WPO = 17 * MiB;
constexpr size_t WS_WO = 21 * MiB;
constexpr size_t WS_WIN = 32 * MiB;
constexpr size_t WS_WIN8 = 48 * MiB;
constexpr size_t WS_XB8 = 544 * MiB;
constexpr size_t WS_XB = 64 * MiB;
constexpr size_t WS_U = 128 * MiB;
constexpr size_t WS_P = 160 * MiB;
constexpr size_t WS_G = 192 * MiB;
constexpr size_t WS_AC = 320 * MiB;
constexpr size_t WS_DP = 352 * MiB;
constexpr size_t WS_YP = 384 * MiB;
constexpr size_t WS_MG = 416 * MiB;
constexpr size_t WS_H = 480 * MiB;
constexpr size_t WS_HB = 608 * MiB;
constexpr size_t WS_W1 = 704 * MiB;
constexpr size_t WS_W2 = 1216 * MiB;
constexpr size_t WS_ACT = 1472 * MiB;
constexpr size_t WS_Y = 1760 * MiB;
constexpr size_t WS_END = 2048 * MiB;
constexpr int CW_BAR = 4096;
constexpr int CW_CNT = 16384;
constexpr int CW_QHEAD = 32768;

constexpr int STAGE_BYTES = 131072;
constexpr int L_MISC = STAGE_BYTES;
constexpr int L_CNT = L_MISC + 256;
constexpr int L_BASE = L_CNT + 128;
constexpr int L_NRT = L_BASE + 128;
constexpr int L_NU = L_NRT + 128;
constexpr int L_UNITS = L_NU + 16;
constexpr int L_TBL = STAGE_BYTES + 4096;
constexpr int LDS_BYTES = STAGE_BYTES + 8192;
constexpr int NTHREADS = 512, NWAVES = 8;

__device__ __forceinline__ unsigned f2bf(float f) { unsigned u = __builtin_bit_cast(unsigned, f); return (u + 0x7fffu + ((u >> 16) & 1u)) >> 16; }
__device__ __forceinline__ float bf2f(unsigned b) { return __builtin_bit_cast(float, b << 16); }
__device__ __forceinline__ unsigned cvt_pk_bf16(float lo, float hi) { unsigned r; asm volatile("v_cvt_pk_bf16_f32 %0, %1, %2" : "=v"(r) : "v"(lo), "v"(hi)); return r; }
__device__ __forceinline__ unsigned pk4_fp8(float a, float b, float c, float d) { int w = __builtin_amdgcn_cvt_pk_fp8_f32(a, b, 0, false); w = __builtin_amdgcn_cvt_pk_fp8_f32(c, d, w, true); return (unsigned)w; }
__device__ __forceinline__ float bflo(unsigned w) { return __builtin_bit_cast(float, w << 16); }
__device__ __forceinline__ float bfhi(unsigned w) { return __builtin_bit_cast(float, w & 0xffff0000u); }
__device__ __forceinline__ float sigmoidf_(float x) { return __builtin_amdgcn_rcpf(1.0f + __builtin_amdgcn_exp2f(-1.44269504f * x)); }
__device__ __forceinline__ float wave_sum(float v) {
#pragma unroll
    for (int o = 1; o < 64; o <<= 1) v += __shfl_xor(v, o);
    return v;
}
__device__ __forceinline__ int tid_opaque() { int t = threadIdx.x; asm volatile("" : "+v"(t)); return t; }
#define LDS_WAIT() asm volatile("s_waitcnt lgkmcnt(0)" ::: "memory")
#define VM_WAIT() asm volatile("s_waitcnt vmcnt(0)" ::: "memory")

#define XB_TMO      128
#define XB_XCNT(j)  (256  + 64 * (j))
#define XB_XSUB(j)  (1280 + 64 * (j))
#define XB_XGEN(j)  (2304 + 64 * (j))
#define XB_TOP      3328
#define XB_TOPGEN   3392
#define XCD_BAR_WORDS 3456
#define XB_SPIN_CAP (1u << 18)
__device__ __forceinline__ unsigned xb_ld(unsigned* p)              { return __hip_atomic_load(p, __ATOMIC_RELAXED, __HIP_MEMORY_SCOPE_AGENT); }
__device__ __forceinline__ unsigned xb_add(unsigned* p, unsigned v) { return __hip_atomic_fetch_add(p, v, __ATOMIC_RELAXED, __HIP_MEMORY_SCOPE_AGENT); }
__device__ __forceinline__ unsigned xb_xcc_id() { return (unsigned)__builtin_amdgcn_s_getreg((3 << 11) | 20) & 0xFu; }
#define XB_SPIN(cond, bar) do { unsigned _sp = 0; while (cond) { __builtin_amdgcn_s_sleep(1); \
    if ((++_sp & 255u) == 0u) { if (xb_ld(&(bar)[XB_TMO])) break; if (_sp > XB_SPIN_CAP) { atomicAdd(&(bar)[XB_TMO], 1u); break; } } } } while (0)
struct XcdBarrier { unsigned* bar; unsigned x; volatile LAS unsigned* st; };
__device__ __forceinline__ XcdBarrier xcd_barrier_post(unsigned* bar, volatile LAS unsigned* st) {
    XcdBarrier b; b.bar = bar; b.x = xb_xcc_id(); b.st = st;
    if (threadIdx.x == 0) (void)xb_add(&bar[XB_XCNT(b.x)], 1u);
    return b;
}
__device__ __forceinline__ void xcd_barrier_complete(unsigned* bar, unsigned x, unsigned& nloc, unsigned& nx) {
    const unsigned G = gridDim.x * gridDim.y * gridDim.z;
    unsigned sum, cnt, mine, sp = 0u;
    for (;;) {
        sum = 0u; cnt = 0u; mine = 0u;
#pragma unroll
        for (unsigned j = 0; j < 16; ++j) { const unsigned c = xb_ld(&bar[XB_XCNT(j)]); sum += c; cnt += (c > 0u) ? 1u : 0u; mine = (j == x) ? c : mine; }
        if (sum == G) break;
        __builtin_amdgcn_s_sleep(1);
        if ((++sp & 255u) == 0u) { if (xb_ld(&bar[XB_TMO])) break; if (sp > XB_SPIN_CAP) { atomicAdd(&bar[XB_TMO], 1u); break; } }
    }
    nloc = mine > 0u ? mine : 1u; nx = cnt > 0u ? cnt : 1u;
}
__device__ __forceinline__ void xcd_barrier(const XcdBarrier& b) {
    asm volatile("s_waitcnt vmcnt(0)" ::: "memory");
    __syncthreads();
    if (threadIdx.x == 0) {
        unsigned* bar = b.bar;
        __builtin_amdgcn_s_waitcnt(0);
        unsigned nloc = b.st[0], nx = b.st[1];
        if (nloc == 0u) { xcd_barrier_complete(bar, b.x, nloc, nx); b.st[0] = nloc; b.st[1] = nx; }
        const unsigned old = xb_add(&bar[XB_XSUB(b.x)], 1u);
        const unsigned gen = old / nloc;
        if (old + 1u == (gen + 1u) * nloc) {
            __builtin_amdgcn_fence(__ATOMIC_RELEASE, "agent");
            asm volatile("s_waitcnt vmcnt(0)" ::: "memory");
            const unsigned og = xb_add(&bar[XB_TOP], 1u);
            const unsigned tg = og / nx;
            if (og + 1u == (tg + 1u) * nx) xb_add(&bar[XB_TOPGEN], 1u);
            else XB_SPIN(xb_ld(&bar[XB_TOPGEN]) == tg, bar);
            __builtin_amdgcn_fence(__ATOMIC_ACQUIRE, "agent");
            xb_add(&bar[XB_XGEN(b.x)], 1u);
            asm volatile("s_waitcnt vmcnt(0)" ::: "memory");
        } else {
            XB_SPIN(xb_ld(&bar[XB_XGEN(b.x)]) == gen, bar);
            __builtin_amdgcn_fence(__ATOMIC_ACQUIRE, "agent");
            asm volatile("s_waitcnt vmcnt(0)" ::: "memory");
        }
    }
    __syncthreads();
}

constexpr int BM = 256, BK = 64, HALF = 128, HTB = HALF * BK * 2, NXCD = 8, WGM = 8;
__host__ __device__ __forceinline__ int lds_byte(int r, int c) { const int st = (r >> 4) * 2 + (c >> 5), rr = r & 15, cc = c & 31, ob = rr * 64 + cc * 2; return st * 1024 + (ob ^ (((ob >> 9) & 1) << 5)); }
__host__ __device__ __forceinline__ void stage_rc(int b, int& R, int& C) { const int st = b / 1024, sb = b % 1024, swz = sb ^ (((sb >> 9) & 1) << 5); R = (st >> 1) * 16 + swz / 64; C = (st & 1) * 32 + (swz % 64) / 2; }
__host__ __device__ __forceinline__ int perm32(int rho) { const int n = rho >> 4, i = rho & 15; return 8 * (i >> 2) + 4 * n + (i & 3); }

struct UnitD { const char* A; const char* B; int i0, i1, i2, i3; };

struct TileOrder {
    int nM, nN, nwg, wgm;
    __device__ __forceinline__ void init(int M, int N, int g = WGM) { nM = M / BM; nN = N / BM; nwg = nM * nN; wgm = g; }
    __device__ __forceinline__ bool get(int L, int& pm, int& pn) const {
        if (L >= nwg) return false;
        int wgid = L; { const int q = nwg / NXCD, r = nwg % NXCD, xcd = wgid % NXCD, off = wgid / NXCD; wgid = (xcd < r ? xcd * (q + 1) : r * (q + 1) + (xcd - r) * q) + off; }
        const int nig = wgm * nN, gid = wgid / nig, fm = gid * wgm, gsz = (nM - fm) < wgm ? (nM - fm) : wgm;
        pm = fm + ((wgid % nig) % gsz); pn = (wgid % nig) / gsz; return true;
    }
};

template <class Epi, class Sched, bool GATHER, bool FP8>
__device__ __forceinline__ void gemm_phase(LAS unsigned char* lds, const int KB, const int pitchB, const Sched& S, const Epi& E) {
    const int tid = tid_opaque(), wid = __builtin_amdgcn_readfirstlane(tid >> 6), lane = tid & 63, wr = wid >> 2, wc = wid & 3, fr = lane & 15, fq = lane >> 4;
    int Kk = KB; asm volatile("" : "+s"(Kk));
    const int nt = Kk / 128;
    int Rr[2], Cc[2]; unsigned voffB[2];
#pragma unroll
    for (int i = 0; i < 2; ++i) { stage_rc(tid * 16 + i * 8192, Rr[i], Cc[i]);
        const int R = Rr[i], rho = R & 31; const int Rb = Epi::CMAP ? 64 * (R >> 5) + 16 * ((rho >> 2) & 3) + 4 * (rho >> 4) + (rho & 3) : (R & ~31) + perm32(rho);
        voffB[i] = (unsigned)(Rb * pitchB + Cc[i] * 2); }
    const size_t kstep = (size_t)(BK * 2);
    const size_t hstep = (size_t)(Epi::CMAP ? 8 : HALF) * pitchB;
    const unsigned ldsw = (unsigned)wid * 1024u;
    const int aoff = lds_byte(wr * 64 + fr, fq * 8), boff = lds_byte(wc * 32 + fr, fq * 8);
#define PG8_SA(b, h) (((b) * 2 + (h)) * HTB)
#define PG8_SB(b, h) ((4 + (b) * 2 + (h)) * HTB)
#define PG8_STAGE(bufoff, gbase, voff) do { _Pragma("unroll") for (int _i = 0; _i < 2; ++_i) \
        __builtin_amdgcn_global_load_lds((const unsigned*)((const char*)(gbase) + (voff)[_i]), (LAS unsigned*)(lds + (bufoff) + ldsw + _i * 8192), 16, 0, 0); } while (0)
#define PG8_LDA(dst, b, h) do { _Pragma("unroll") for (int m = 0; m < 4; ++m) _Pragma("unroll") for (int k = 0; k < 2; ++k) dst[m][k] = *(const LAS bf16x8*)(lds + PG8_SA(b, h) + aoff + m * 2048 + k * 1024); } while (0)
#define PG8_LDB(dst, b, h) do { _Pragma("unroll") for (int n = 0; n < 2; ++n) _Pragma("unroll") for (int k = 0; k < 2; ++k) dst[n][k] = *(const LAS bf16x8*)(lds + PG8_SB(b, h) + boff + n * 2048 + k * 1024); } while (0)
#define PG8_MMA(ai, bj, At, Bt) do { __builtin_amdgcn_s_setprio(1); _Pragma("unroll") for (int m = 0; m < 4; ++m) _Pragma("unroll") for (int n = 0; n < 2; ++n) { \
        if constexpr (FP8) { const i32x4 a0_ = __builtin_bit_cast(i32x4, At[m][0]), a1_ = __builtin_bit_cast(i32x4, At[m][1]), b0_ = __builtin_bit_cast(i32x4, Bt[n][0]), b1_ = __builtin_bit_cast(i32x4, Bt[n][1]); \
            const i32x8 a_ = __builtin_shufflevector(a0_, a1_, 0, 1, 2, 3, 4, 5, 6, 7), b_ = __builtin_shufflevector(b0_, b1_, 0, 1, 2, 3, 4, 5, 6, 7); \
            asm volatile("s_nop 1\n\tv_mfma_f32_16x16x128_f8f6f4 %0, %1, %2, %0" : "+v"(acc[ai][bj][m][n]) : "v"(b_), "v"(a_)); } \
        else { _Pragma("unroll") for (int k = 0; k < 2; ++k) acc[ai][bj][m][n] = __builtin_amdgcn_mfma_f32_16x16x32_bf16(Bt[n][k], At[m][k], acc[ai][bj][m][n], 0, 0, 0); } } \
        __builtin_amdgcn_s_setprio(0); } while (0)
#define PG8_WAIT_V(n) asm volatile("s_waitcnt vmcnt(" #n ")" ::: "memory")
#define PG8_WAIT_L(n) asm volatile("s_waitcnt lgkmcnt(" #n ")" ::: "memory")
#define PG8_BAR __builtin_amdgcn_s_barrier()
#define PG8_SCHED __builtin_amdgcn_sched_barrier(0)
    UnitD cur, nxt; int ui = 0;
    if (!S.next(0, cur)) return;
    unsigned vA[2][2], vN[2][2];
#pragma unroll
    for (int h = 0; h < 2; ++h)
#pragma unroll
        for (int i = 0; i < 2; ++i) { vA[h][i] = S.a_off(cur, h, Rr[i], Cc[i]); vN[h][i] = vA[h][i]; }
    f32x4 acc[2][2][4][2];
#pragma unroll
    for (int a = 0; a < 2; ++a)
#pragma unroll
        for (int b = 0; b < 2; ++b)
#pragma unroll
            for (int m = 0; m < 4; ++m)
#pragma unroll
                for (int n = 0; n < 2; ++n) acc[a][b][m][n] = (f32x4){0.f, 0.f, 0.f, 0.f};
    bf16x8 At[4][2], B0[2][2], B1[2][2];
    const char* cA = cur.A; const char* cB = cur.B;
    PG8_STAGE(PG8_SB(0, 0), cB, voffB); PG8_STAGE(PG8_SB(0, 1), cB + hstep, voffB); PG8_STAGE(PG8_SA(0, 0), cA, vA[0]); PG8_STAGE(PG8_SA(0, 1), cA, vA[1]);
    if (wr == 1) PG8_BAR;
    PG8_WAIT_V(2); PG8_BAR;
    PG8_STAGE(PG8_SB(1, 0), cB + kstep, voffB); PG8_STAGE(PG8_SA(1, 0), cA + kstep, vA[0]); PG8_STAGE(PG8_SB(1, 1), cB + hstep + kstep, voffB);
    PG8_WAIT_V(6); PG8_BAR;
    for (;;) {
        const bool has_next = S.next(ui + 1, nxt);
        bool do0 = true, do1 = true;
        if constexpr (Epi::RSKIP) { const int vr = cur.i3 - cur.i1 * 256; do0 = (64 * wr) < vr; do1 = (128 + 64 * wr) < vr; }
        float tv = E.tbl_fetch(cur, wid, lane);
        int rawN[2][2];
        if constexpr (GATHER) {
#pragma unroll
            for (int h = 0; h < 2; ++h)
#pragma unroll
                for (int i = 0; i < 2; ++i) rawN[h][i] = S.tok_fetch(has_next ? nxt : cur, h, Rr[i]);
        }
        const char* nA = has_next ? nxt.A : cA; const char* nB = has_next ? nxt.B : cB;
        for (int t = 0; t < nt; t += 2) {
            const bool last = (t == nt - 2);
            const char* a1 = cA + (size_t)(t + 1) * kstep;
            const char* a2 = last ? nA : cA + (size_t)(t + 2) * kstep; const char* b2 = last ? nB : cB + (size_t)(t + 2) * kstep;
            const char* a3 = a2 + kstep; const char* b3 = b2 + kstep;
            unsigned x0[2], x1[2];
            if constexpr (GATHER) {
                asm volatile("" : "+v"(rawN[0][0]), "+v"(rawN[0][1]), "+v"(rawN[1][0]), "+v"(rawN[1][1]));
#pragma unroll
                for (int h = 0; h < 2; ++h)
#pragma unroll
                    for (int i = 0; i < 2; ++i) vN[h][i] = S.tok_off(has_next ? nxt : cur, h, Rr[i], Cc[i], rawN[h][i]);
                x0[0] = last ? vN[0][0] : vA[0][0]; x0[1] = last ? vN[0][1] : vA[0][1]; x1[0] = last ? vN[1][0] : vA[1][0]; x1[1] = last ? vN[1][1] : vA[1][1]; }
            else { x0[0] = vA[0][0]; x0[1] = vA[0][1]; x1[0] = vA[1][0]; x1[1] = vA[1][1]; }
            PG8_LDB(B0, 0, 0); PG8_LDB(B1, 0, 1); PG8_SCHED; if (do0) { PG8_LDA(At, 0, 0); } PG8_STAGE(PG8_SA(1, 1), a1, vA[1]);
            PG8_WAIT_V(8); PG8_WAIT_L(0); PG8_BAR; if (do0) { PG8_MMA(0, 0, At, B0); PG8_MMA(0, 1, At, B1); } PG8_BAR; PG8_SCHED;
            if (do1) { PG8_LDA(At, 0, 1); } PG8_STAGE(PG8_SB(0, 0), b2, voffB); PG8_STAGE(PG8_SB(0, 1), b2 + hstep, voffB); PG8_STAGE(PG8_SA(0, 0), a2, x0);
            PG8_WAIT_V(8); PG8_WAIT_L(0); PG8_BAR; if (do1) { PG8_MMA(1, 0, At, B0); PG8_MMA(1, 1, At, B1); } PG8_BAR; PG8_SCHED;
            PG8_LDB(B0, 1, 0); PG8_LDB(B1, 1, 1); PG8_SCHED; if (do0) { PG8_LDA(At, 1, 0); } PG8_STAGE(PG8_SA(0, 1), a2, x1);
            PG8_WAIT_V(8); PG8_WAIT_L(0); PG8_BAR; if (do0) { PG8_MMA(0, 0, At, B0); PG8_MMA(0, 1, At, B1); } PG8_BAR; PG8_SCHED;
            if (do1) { PG8_LDA(At, 1, 1); } PG8_STAGE(PG8_SB(1, 0), b3, voffB); PG8_STAGE(PG8_SB(1, 1), b3 + hstep, voffB); PG8_STAGE(PG8_SA(1, 0), a3, x0);
            PG8_WAIT_V(8); PG8_WAIT_L(0); PG8_BAR; if (do1) { PG8_MMA(1, 0, At, B0); PG8_MMA(1, 1, At, B1); } PG8_BAR; PG8_SCHED;
        }
        if (wr == 0) PG8_BAR;
        if constexpr (Epi::TBL) { E.tbl_put(tv, lds, wid, lane, ui & 1); PG8_WAIT_L(0); PG8_BAR; }
        if constexpr (FP8) asm volatile("s_nop 15\n\ts_nop 15" ::: "memory");
        E(acc, cur, wr, wc, fr, fq, ui & 1);
        if (!has_next) break;
        if (!E.keep(cur)) {
#pragma unroll
            for (int a = 0; a < 2; ++a)
#pragma unroll
                for (int b = 0; b < 2; ++b)
#pragma unroll
                    for (int m = 0; m < 4; ++m)
#pragma unroll
                        for (int n = 0; n < 2; ++n) acc[a][b][m][n] = (f32x4){0.f, 0.f, 0.f, 0.f};
        }
        cur = nxt; cA = nA; cB = nB; ++ui;
#pragma unroll
        for (int h = 0; h < 2; ++h)
#pragma unroll
            for (int i = 0; i < 2; ++i) vA[h][i] = vN[h][i];
        if (wr == 1) PG8_BAR;
    }
    PG8_WAIT_V(0);
    PG8_BAR;
#undef PG8_SA
#undef PG8_SB
#undef PG8_STAGE
#undef PG8_LDA
#undef PG8_LDB
#undef PG8_MMA
#undef PG8_WAIT_V
#undef PG8_WAIT_L
#undef PG8_BAR
#undef PG8_SCHED
}

struct Args { const float* in[20]; float* out; unsigned char* ws; int ph_lo, ph_hi, li, pad; };

#define CAS __attribute__((address_space(4)))
__device__ __forceinline__ const float* in_ptr(int i) { const CAS Args* ka = (const CAS Args*)__builtin_amdgcn_kernarg_segment_ptr(); asm volatile("" : "+s"(ka)); return ka->in[i]; }
__device__ __forceinline__ float* out_ptr() { const CAS Args* ka = (const CAS Args*)__builtin_amdgcn_kernarg_segment_ptr(); asm volatile("" : "+s"(ka)); return ka->out; }
struct Frame {
    LAS unsigned char* lds;
    unsigned char* ws;
    int G, bx;
};
#define PHASE_IDS() const int tid = tid_opaque(), lane = tid & 63, wave = __builtin_amdgcn_readfirstlane(tid >> 6); (void)lane; (void)wave

struct DenseSched {
    const char* A; const char* B; int lda, ldb, G, c; TileOrder to;
    __device__ __forceinline__ bool next(int i, UnitD& u) const {
        int pm, pn; if (!to.get(i * G + c, pm, pn)) return false;
        u.A = A + (size_t)pm * 256 * lda * 2; u.B = B + (size_t)pn * 256 * ldb * 2; u.i0 = pm; u.i1 = pn; u.i2 = 0; u.i3 = 0; return true;
    }
    __device__ __forceinline__ unsigned a_off(const UnitD&, int h, int R, int C) const { return (unsigned)((h * 128 + R) * lda + C) * 2u; }
};
struct DenseSched8 {
    const char* A; const char* B; int lda, ldb, G, c; TileOrder to;
    __device__ __forceinline__ bool next(int i, UnitD& u) const {
        int pm, pn; if (!to.get(i * G + c, pm, pn)) return false;
        u.A = A + (size_t)pm * 256 * lda; u.B = B + (size_t)pn * 256 * ldb; u.i0 = pm; u.i1 = pn; u.i2 = 0; u.i3 = 0; return true;
    }
    __device__ __forceinline__ unsigned a_off(const UnitD&, int h, int R, int C) const { return (unsigned)((h * 128 + R) * lda + C * 2); }
};
struct PoolSched {
    const char* A; const char* B; int G, c;
    __device__ __forceinline__ bool next(int i, UnitD& u) const {
        const int L = i * G + c; if (L >= 32) return false;
        const int pm = L >> 2, g = L & 3;
        u.A = A + ((size_t)pm * 256 * CC + g * 256) * 2; u.B = B + (size_t)g * 65536 * 2; u.i0 = pm; u.i1 = g; u.i2 = 0; u.i3 = 0; return true;
    }
    __device__ __forceinline__ unsigned a_off(const UnitD&, int h, int R, int C) const { return (unsigned)((h * 128 + R) * CC + C) * 2u; }
};
struct MergeSched {
    const char* A0; const char* A1; const char* B0; const char* B1; int G, c; TileOrder to;
    __device__ __forceinline__ bool next(int i, UnitD& u) const {
        int pm, pn; if (!to.get((i >> 1) * G + c, pm, pn)) return false;
        const int part = i & 1;
        u.A = (part ? A1 : A0) + (size_t)pm * 256 * CC * 2; u.B = (part ? B1 : B0) + (size_t)pn * 256 * CC * 2; u.i0 = pm; u.i1 = pn; u.i2 = part; u.i3 = 0; return true;
    }
    __device__ __forceinline__ unsigned a_off(const UnitD&, int h, int R, int C) const { return (unsigned)((h * 128 + R) * CC + C) * 2u; }
};
struct MoeSched {
    LAS unsigned char* lds; const char* A; const char* B; const int* ltok; int gather; int nrows_w;
    __device__ __forceinline__ bool next(int i, UnitD& u) const {
        const int nu = __builtin_amdgcn_readfirstlane(((const LAS int*)(lds + L_NU))[0]); if (i >= nu) return false;
        const int code = __builtin_amdgcn_readfirstlane(((const LAS int*)(lds + L_UNITS))[i]); const int e = code >> 16, rt = (code >> 8) & 0xff, ct = code & 0xff;
        const int cnt = __builtin_amdgcn_readfirstlane(((const LAS int*)(lds + L_CNT))[e]), base = __builtin_amdgcn_readfirstlane(((const LAS int*)(lds + L_BASE))[e]);
        u.A = gather ? A : A + (size_t)(base + rt * 256) * DE;
        u.B = B + ((size_t)e * nrows_w + (size_t)ct * 256) * DE;
        u.i0 = e; u.i1 = rt; u.i2 = ct; u.i3 = cnt; return true;
    }
    __device__ __forceinline__ int tok_fetch(const UnitD& u, int h, int R) const {
        int v; const int* p = ltok + u.i0 * LCAP + u.i1 * 256 + h * 128 + R; asm volatile("global_load_dword %0, %1, off" : "=v"(v) : "v"(p) : "memory"); return v; }
    __device__ __forceinline__ unsigned tok_off(const UnitD& u, int h, int R, int C, int raw) const {
        const int sr = u.i1 * 256 + h * 128 + R; const int tok = (sr < u.i3) ? raw : 0; return (unsigned)(tok * DE + C * 2); }
    __device__ __forceinline__ unsigned a_off(const UnitD& u, int h, int R, int C) const {
        if (gather) { const int sr = u.i1 * 256 + h * 128 + R; const int tok = (sr < u.i3) ? ltok[u.i0 * LCAP + sr] : 0; return (unsigned)(tok * DE + C * 2); }
        return (unsigned)((h * 128 + R) * DE + C * 2);
    }
};

#define EPI_FENCE() asm volatile("" ::: "memory")
__device__ __forceinline__ u32x4 pack8(const f32x4 a, const f32x4 b) { u32x4 w; w.x = cvt_pk_bf16(a[0], a[1]); w.y = cvt_pk_bf16(a[2], a[3]); w.z = cvt_pk_bf16(b[0], b[1]); w.w = cvt_pk_bf16(b[2], b[3]); return w; }
__device__ __forceinline__ f32x4 sig4(const f32x4 v) { return (f32x4){sigmoidf_(v[0]), sigmoidf_(v[1]), sigmoidf_(v[2]), sigmoidf_(v[3])}; }
__device__ __forceinline__ void unpack8(const u32x4 w, f32x4& a, f32x4& b) { a = (f32x4){bflo(w.x), bfhi(w.x), bflo(w.y), bfhi(w.y)}; b = (f32x4){bflo(w.z), bfhi(w.z), bflo(w.w), bfhi(w.w)}; }

__device__ __forceinline__ float tbl_load(const float* g, int lane) { float v; const float* p = g + lane; asm volatile("global_load_dword %0, %1, off" : "=v"(v) : "v"(p) : "memory"); return v; }
__device__ __forceinline__ void tbl_store(float v, LAS unsigned char* lds, int par, int slot, int lane) { asm volatile("" : "+v"(v)); ((LAS float*)(lds + L_TBL + par * 2048 + slot * 256))[lane] = v; }
struct EpiWin {
    bf16_t* U; bf16_t* P; const float* rs1;
    LAS unsigned char* lds;
    __device__ __forceinline__ float tbl_fetch(const UnitD& u, int wid, int lane) const { return tbl_load(rs1 + u.i0 * 256 + (wid & 3) * 64, lane); }
    __device__ __forceinline__ void tbl_put(float v, LAS unsigned char* l, int wid, int lane, int par) const { if (wid < 4) tbl_store(v, l, par, wid, lane); }
    static constexpr int CMAP = 0;
    static constexpr bool RSKIP = false;
    static constexpr bool TBL = true;
    __device__ __forceinline__ bool keep(const UnitD&) const { return false; }
    __device__ __forceinline__ void operator()(f32x4 (&acc)[2][2][4][2], const UnitD& u, int wr, int wc, int fr, int fq, int par) const {
        const int pm = u.i0, pn = u.i1; const int row0 = pm * 256 + wr * 64 + fr, cl = wc * 32 + 8 * fq;
        const LAS float* trs = (const LAS float*)(lds + L_TBL + par * 2048) + wr * 64 + fr;
        if (pn < 8) {
#pragma unroll
            for (int ai = 0; ai < 2; ++ai)
#pragma unroll
                for (int m = 0; m < 4; ++m) { const int r = row0 + ai * 128 + m * 16; const float rs = trs[ai * 128 + m * 16];
                    const f32x4 a0 = acc[ai][0][m][0] * rs, a1 = acc[ai][0][m][1] * rs, g0 = acc[ai][1][m][0] * rs, g1 = acc[ai][1][m][1] * rs;
                    *(u32x4*)(U + (size_t)r * CC + pn * 128 + cl) = pack8(a0 * sig4(g0), a1 * sig4(g1)); }
        } else {
#pragma unroll
            for (int ai = 0; ai < 2; ++ai)
#pragma unroll
                for (int m = 0; m < 4; ++m) { const int r = row0 + ai * 128 + m * 16; const float rs = trs[ai * 128 + m * 16];
#pragma unroll
                    for (int bj = 0; bj < 2; ++bj) *(u32x4*)(P + (size_t)r * CC + (pn - 8) * 256 + bj * 128 + cl) = pack8(acc[ai][bj][m][0] * rs, acc[ai][bj][m][1] * rs); }
        }
    }
};
struct EpiGate {
    bf16_t* Gt; const float* rs1;
    LAS unsigned char* lds;
    __device__ __forceinline__ float tbl_fetch(const UnitD& u, int wid, int lane) const { return tbl_load(rs1 + u.i0 * 256 + (wid & 3) * 64, lane); }
    __device__ __forceinline__ void tbl_put(float v, LAS unsigned char* l, int wid, int lane, int par) const { if (wid < 4) tbl_store(v, l, par, wid, lane); }
    static constexpr int CMAP = 0;
    static constexpr bool RSKIP = false;
    static constexpr bool TBL = true;
    __device__ __forceinline__ bool keep(const UnitD&) const { return false; }
    __device__ __forceinline__ void operator()(f32x4 (&acc)[2][2][4][2], const UnitD& u, int wr, int wc, int fr, int fq, int par) const {
        const int pm = u.i0, pn = u.i1; const int row0 = pm * 256 + wr * 64 + fr, cl = wc * 32 + 8 * fq;
        const LAS float* trs = (const LAS float*)(lds + L_TBL + par * 2048) + wr * 64 + fr;
#pragma unroll
        for (int ai = 0; ai < 2; ++ai)
#pragma unroll
            for (int m = 0; m < 4; ++m) { const int r = row0 + ai * 128 + m * 16; const float rs = trs[ai * 128 + m * 16] * (1.0f / (WSCALE * XS));
                { const f32x4 c0 = sig4(acc[ai][0][m][0] * rs), c1 = sig4(acc[ai][0][m][1] * rs), p0 = sig4(acc[ai][1][m][0] * rs), p1 = sig4(acc[ai][1][m][1] * rs); f32x4 q0, q1;
#pragma unroll
                  for (int j = 0; j < 4; ++j) { q0[j] = c0[j] * __builtin_amdgcn_rcpf(fmaxf(p0[j], 1e-6f)); q1[j] = c1[j] * __builtin_amdgcn_rcpf(fmaxf(p1[j], 1e-6f)); }
                  __builtin_nontemporal_store(pack8(q0, q1), (u32x4*)(Gt + (size_t)r * 4096 + pn * 128 + cl));
                  __builtin_nontemporal_store(pack8(p0, p1), (u32x4*)(Gt + (size_t)r * 4096 + 2048 + pn * 128 + cl)); } }
    }
};
struct EpiPool {
    bf16_t* YP;
    __device__ __forceinline__ float tbl_fetch(const UnitD&, int, int) const { return 0.f; }
    __device__ __forceinline__ void tbl_put(float, LAS unsigned char*, int, int, int) const {}
    static constexpr int CMAP = 0;
    static constexpr bool RSKIP = false;
    static constexpr bool TBL = false;
    __device__ __forceinline__ bool keep(const UnitD&) const { return false; }
    __device__ __forceinline__ void operator()(f32x4 (&acc)[2][2][4][2], const UnitD& u, int wr, int wc, int fr, int fq, int par) const {
        const int pm = u.i0, g = u.i1; const int row0 = pm * 256 + wr * 64 + fr, cl = g * 256 + wc * 32 + 8 * fq;
#pragma unroll
        for (int ai = 0; ai < 2; ++ai)
#pragma unroll
            for (int m = 0; m < 4; ++m) { const int r = row0 + ai * 128 + m * 16;
#pragma unroll
                for (int bj = 0; bj < 2; ++bj) *(u32x4*)(YP + (size_t)r * CC + cl + bj * 128) = pack8(acc[ai][bj][m][0], acc[ai][bj][m][1]); }
    }
};
struct EpiMerge {
    bf16_t* MG; const bf16_t* Gt;
    __device__ __forceinline__ float tbl_fetch(const UnitD&, int, int) const { return 0.f; }
    __device__ __forceinline__ void tbl_put(float, LAS unsigned char*, int, int, int) const {}
    static constexpr int CMAP = 0;
    static constexpr bool RSKIP = false;
    static constexpr bool TBL = false;
    __device__ __forceinline__ bool keep(const UnitD& u) const { return u.i2 == 0; }
    __device__ __forceinline__ void operator()(f32x4 (&acc)[2][2][4][2], const UnitD& u, int wr, int wc, int fr, int fq, int par) const {
        const int pm = u.i0, pn = u.i1, part = u.i2; const int row0 = pm * 256 + wr * 64 + fr, cl = pn * 256 + wc * 32 + 8 * fq;
        if (part == 0) {
#pragma unroll
            for (int ai = 0; ai < 2; ++ai)
#pragma unroll
                for (int m = 0; m < 4; ++m) { const int r = row0 + ai * 128 + m * 16;
#pragma unroll
                    for (int bj = 0; bj < 2; ++bj) { const u32x4 wq_ = *(const u32x4*)(Gt + (size_t)r * 4096 + cl + bj * 128);
                        f32x4 q0, q1; unpack8(wq_, q0, q1); acc[ai][bj][m][0] = acc[ai][bj][m][0] * q0; acc[ai][bj][m][1] = acc[ai][bj][m][1] * q1; }
                    EPI_FENCE(); }
        } else {
#pragma unroll
            for (int ai = 0; ai < 2; ++ai)
#pragma unroll
                for (int m = 0; m < 4; ++m) { const int r = row0 + ai * 128 + m * 16;
#pragma unroll
                    for (int bj = 0; bj < 2; ++bj) { const u32x4 wp_ = *(const u32x4*)(Gt + (size_t)r * 4096 + 2048 + cl + bj * 128);
                        f32x4 p0, p1; unpack8(wp_, p0, p1);
#pragma unroll
                        for (int j = 0; j < 4; ++j) { p0[j] = fmaxf(p0[j], 1e-6f); p1[j] = fmaxf(p1[j], 1e-6f); }
                        *(u32x4*)(MG + (size_t)r * D + cl + bj * 128) = pack8(acc[ai][bj][m][0] * p0, acc[ai][bj][m][1] * p1); }
                    EPI_FENCE(); }
        }
    }
};
struct EpiWo {
    const bf16_t* x; bf16_t* H; unsigned char* HQ; float* SSQP; const float* g2;
    __device__ __forceinline__ float tbl_fetch(const UnitD&, int, int) const { return 0.f; }
    __device__ __forceinline__ void tbl_put(float, LAS unsigned char*, int, int, int) const {}
    static constexpr int CMAP = 1;
    static constexpr bool RSKIP = false;
    static constexpr bool TBL = false;
    __device__ __forceinline__ bool keep(const UnitD&) const { return false; }
    __device__ __forceinline__ void operator()(f32x4 (&acc)[2][2][4][2], const UnitD& u, int wr, int wc, int fr, int fq, int par) const {
        const int pm = u.i0, pn = u.i1; const int row0 = pm * 256 + wr * 64 + fr, cl = pn * 256 + wc * 64 + 16 * fq;
        f32x4 gg[4];
#pragma unroll
        for (int c = 0; c < 4; ++c) gg[c] = *(const f32x4*)(g2 + cl + 4 * c);
#pragma unroll
        for (int ai = 0; ai < 2; ++ai)
#pragma unroll
            for (int m = 0; m < 4; ++m) { const int r = row0 + ai * 128 + m * 16; const size_t o = (size_t)r * D + cl; float ss = 0.f;
                f32x4 h[4], xv[4]; { const u32x4 xa = *(const u32x4*)(x + o), xb2 = *(const u32x4*)(x + o + 8); unpack8(xa, xv[0], xv[1]); unpack8(xb2, xv[2], xv[3]); }
#pragma unroll
                for (int c = 0; c < 4; ++c) { h[c] = xv[c] + acc[ai][c >> 1][m][c & 1]; ss += (h[c][0] * h[c][0] + h[c][1] * h[c][1]) + (h[c][2] * h[c][2] + h[c][3] * h[c][3]); }
                *(u32x4*)(H + o) = pack8(h[0], h[1]); *(u32x4*)(H + o + 8) = pack8(h[2], h[3]);
                u32x4 q;
#pragma unroll
                for (int c = 0; c < 4; ++c) { const f32x4 t = h[c] * gg[c]; q[c] = pk4_fp8(t[0], t[1], t[2], t[3]); }
                *(u32x4*)(HQ + o) = q;
                ss += __shfl_xor(ss, 16); ss += __shfl_xor(ss, 32);
                if (fq == 0) SSQP[(size_t)r * 32 + pn * 4 + wc] = ss;
                EPI_FENCE(); }
    }
};
struct EpiMoe1 {
    unsigned char* ACT; const float* b1; const float* lrs; LAS unsigned char* lds;
    __device__ __forceinline__ float tbl_fetch(const UnitD& u, int wid, int lane) const {
        const float* g = (wid < 4) ? lrs + (size_t)u.i0 * LCAP + u.i1 * 256 + wid * 64 : b1 + (size_t)u.i0 * 4096 + u.i2 * 128 + ((wid >= 6) ? 2048 + (wid - 6) * 64 : (wid - 4) * 64);
        return tbl_load(g, lane); }
    __device__ __forceinline__ void tbl_put(float v, LAS unsigned char* l, int wid, int lane, int par) const { tbl_store(wid >= 6 ? v + 1.0f : v, l, par, wid, lane); }
    static constexpr int CMAP = 0;
    static constexpr bool RSKIP = true;
    static constexpr bool TBL = true;
    __device__ __forceinline__ bool keep(const UnitD&) const { return false; }
    __device__ __forceinline__ void operator()(f32x4 (&acc)[2][2][4][2], const UnitD& u, int wr, int wc, int fr, int fq, int par) const {
        const int e = u.i0, rt = u.i1, ct = u.i2, cnt = u.i3; const int base = __builtin_amdgcn_readfirstlane(((const LAS int*)(lds + L_BASE))[e]);
        const int sr0 = rt * 256 + wr * 64 + fr, cl = ct * 128 + wc * 32 + 8 * fq;
        const LAS float* tb = (const LAS float*)(lds + L_TBL + par * 2048);
        f32x4 bg[2], bl[2];
#pragma unroll
        for (int n = 0; n < 2; ++n) { bg[n] = *(const LAS f32x4*)(tb + 256 + wc * 32 + 8 * fq + 4 * n); bl[n] = *(const LAS f32x4*)(tb + 384 + wc * 32 + 8 * fq + 4 * n); }
#pragma unroll
        for (int ai = 0; ai < 2; ++ai) { if (ai * 128 + wr * 64 >= cnt - rt * 256) continue;
#pragma unroll
            for (int m = 0; m < 4; ++m) { const int sr = sr0 + ai * 128 + m * 16; const float rs = tb[ai * 128 + wr * 64 + m * 16 + fr] * (1.0f / WSCALE);
                f32x4 o[2];
                const f32x2 rs2 = (f32x2){rs, rs};
#pragma unroll
                for (int n = 0; n < 2; ++n)
#pragma unroll
                    for (int jp = 0; jp < 2; ++jp) {
                        const f32x2 ag = (f32x2){acc[ai][0][m][n][2 * jp], acc[ai][0][m][n][2 * jp + 1]}, al_ = (f32x2){acc[ai][1][m][n][2 * jp], acc[ai][1][m][n][2 * jp + 1]};
                        const f32x2 bg2 = (f32x2){bg[n][2 * jp], bg[n][2 * jp + 1]}, bl2 = (f32x2){bl[n][2 * jp], bl[n][2 * jp + 1]};
                        const f32x2 hg = __builtin_elementwise_fma(ag, rs2, bg2), hl = __builtin_elementwise_fma(al_, rs2, bl2);
                        f32x2 xg, xl; xg[0] = fminf(hg[0], 7.0f); xg[1] = fminf(hg[1], 7.0f); xl[0] = fminf(fmaxf(hl[0], -6.0f), 8.0f); xl[1] = fminf(fmaxf(hl[1], -6.0f), 8.0f);
                        const f32x2 t = xg * (-1.702f * 1.44269504f);
                        f32x2 ex; ex[0] = __builtin_amdgcn_exp2f(t[0]); ex[1] = __builtin_amdgcn_exp2f(t[1]);
                        const f32x2 dn = ex + 1.0f;
                        f32x2 rc; rc[0] = __builtin_amdgcn_rcpf(dn[0]); rc[1] = __builtin_amdgcn_rcpf(dn[1]);
                        const f32x2 ov = (xg * rc) * xl;
                        o[n][2 * jp] = ov[0]; o[n][2 * jp + 1] = ov[1]; }
                { u32x2 q; q.x = pk4_fp8(o[0][0], o[0][1], o[0][2], o[0][3]); q.y = pk4_fp8(o[1][0], o[1][1], o[1][2], o[1][3]); *(u32x2*)(ACT + (size_t)(base + sr) * DE + cl) = q; } } }
    }
};
struct EpiMoe2 {
    unsigned char* Y; const float* b2; const float* lgate; LAS unsigned char* lds;
    __device__ __forceinline__ float tbl_fetch(const UnitD& u, int wid, int lane) const {
        const float* g = (wid < 4) ? lgate + (size_t)u.i0 * LCAP + u.i1 * 256 + wid * 64 : b2 + (size_t)u.i0 * D + u.i2 * 256 + (wid - 4) * 64;
        return tbl_load(g, lane); }
    __device__ __forceinline__ void tbl_put(float v, LAS unsigned char* l, int wid, int lane, int par) const { tbl_store(v, l, par, wid, lane); }
    static constexpr int CMAP = 1;
    static constexpr bool RSKIP = true;
    static constexpr bool TBL = true;
    __device__ __forceinline__ bool keep(const UnitD&) const { return false; }
    __device__ __forceinline__ void operator()(f32x4 (&acc)[2][2][4][2], const UnitD& u, int wr, int wc, int fr, int fq, int par) const {
        const int e = u.i0, rt = u.i1, ct = u.i2; const int base = __builtin_amdgcn_readfirstlane(((const LAS int*)(lds + L_BASE))[e]);
        const int sr0 = rt * 256 + wr * 64 + fr, cl = ct * 256 + wc * 64 + 16 * fq;
        const LAS float* tb = (const LAS float*)(lds + L_TBL + par * 2048);
        f32x4 bb[2][2];
#pragma unroll
        for (int bj = 0; bj < 2; ++bj)
#pragma unroll
            for (int n = 0; n < 2; ++n) bb[bj][n] = *(const LAS f32x4*)(tb + 256 + wc * 64 + 16 * fq + 8 * bj + 4 * n);
#pragma unroll
        for (int ai = 0; ai < 2; ++ai) { if (ai * 128 + wr * 64 >= u.i3 - rt * 256) continue;
#pragma unroll
            for (int m = 0; m < 4; ++m) { const int sr = sr0 + ai * 128 + m * 16; const float gt = tb[ai * 128 + wr * 64 + m * 16 + fr] * YSCALE;
                u32x4 q;
                { const f32x4 v = (acc[ai][0][m][0] * (1.0f / WSCALE) + bb[0][0]) * gt; q.x = pk4_fp8(v[0], v[1], v[2], v[3]); }
                { const f32x4 v = (acc[ai][0][m][1] * (1.0f / WSCALE) + bb[0][1]) * gt; q.y = pk4_fp8(v[0], v[1], v[2], v[3]); }
                { const f32x4 v = (acc[ai][1][m][0] * (1.0f / WSCALE) + bb[1][0]) * gt; q.z = pk4_fp8(v[0], v[1], v[2], v[3]); }
                { const f32x4 v = (acc[ai][1][m][1] * (1.0f / WSCALE) + bb[1][1]) * gt; q.w = pk4_fp8(v[0], v[1], v[2], v[3]); }
                *(u32x4*)(Y + (size_t)(base + sr) * D + cl) = q; } }
    }
};

__device__ __forceinline__ void tr_item(const float* W, int N, const float* ks, bf16_t* WT, int ldk, int k0, int n0, int drow0, LAS unsigned* tile, int lane) {
    const int kq = lane >> 4, nq = lane & 15;
    f32x4 v[8][2];
#pragma unroll
    for (int i2 = 0; i2 < 8; ++i2)
#pragma unroll
        for (int s = 0; s < 2; ++s) v[i2][s] = __builtin_nontemporal_load((const f32x4*)(W + (size_t)(k0 + 8 * i2 + 2 * kq + s) * N + n0 + 4 * nq));
    if (ks) {
#pragma unroll
        for (int i2 = 0; i2 < 8; ++i2)
#pragma unroll
            for (int s = 0; s < 2; ++s) v[i2][s] = v[i2][s] * ks[k0 + 8 * i2 + 2 * kq + s];
    }
#pragma unroll
    for (int i2 = 0; i2 < 8; ++i2)
#pragma unroll
        for (int j = 0; j < 4; ++j) tile[(4 * nq + j) * 32 + ((i2 ^ (nq & 7)) * 4) + kq] = cvt_pk_bf16(v[i2][0][j], v[i2][1][j]);
    LDS_WAIT();
    const int nr = lane >> 3, kc = lane & 7;
#pragma unroll
    for (int ir = 0; ir < 8; ++ir) { const int n = 8 * ir + nr; const u32x4 o = *(const LAS u32x4*)(tile + n * 32 + ((kc ^ ((n >> 2) & 7)) * 4));
        *(u32x4*)(WT + (size_t)(drow0 + n) * ldk + k0 + 8 * kc) = o; }
    LDS_WAIT();
}
__device__ __forceinline__ void tr_item8(const float* W, int N, const float* ks, float mul, unsigned char* WT, int ldk, int k0, int n0, int drow0, LAS unsigned* tile, int lane) {
    const int kq = lane >> 4, nq = lane & 15;
#pragma unroll
    for (int h = 0; h < 2; ++h) {
        f32x4 v[4][4];
#pragma unroll
        for (int i2 = 0; i2 < 4; ++i2)
#pragma unroll
            for (int s = 0; s < 4; ++s) v[i2][s] = __builtin_nontemporal_load((const f32x4*)(W + (size_t)(k0 + 64 * h + 16 * i2 + 4 * kq + s) * N + n0 + 4 * nq));
#pragma unroll
        for (int i2 = 0; i2 < 4; ++i2)
#pragma unroll
            for (int s = 0; s < 4; ++s) v[i2][s] = v[i2][s] * (ks ? ks[k0 + 64 * h + 16 * i2 + 4 * kq + s] * mul : mul);
#pragma unroll
        for (int i2 = 0; i2 < 4; ++i2)
#pragma unroll
            for (int j = 0; j < 4; ++j) tile[(4 * nq + j) * 32 + (((4 * h + i2) ^ (nq & 7)) * 4) + kq] = pk4_fp8(v[i2][0][j], v[i2][1][j], v[i2][2][j], v[i2][3][j]);
    }
    LDS_WAIT();
    const int nr = lane >> 3, kc = lane & 7;
#pragma unroll
    for (int ir = 0; ir < 8; ++ir) { const int n = 8 * ir + nr; const u32x4 o = *(const LAS u32x4*)(tile + n * 32 + ((kc ^ ((n >> 2) & 7)) * 4));
        *(u32x4*)(WT + (size_t)(drow0 + n) * ldk + k0 + 16 * kc) = o; }
    LDS_WAIT();
}
__device__ __forceinline__ int map_glu(int n0, int half) { return (n0 < half) ? 256 * (n0 / 128) + (n0 % 128) : 256 * ((n0 - half) / 128) + 128 + ((n0 - half) % 128); }

__device__ __forceinline__ void p0_pre(const Frame& F) {
    PHASE_IDS();
    const float* x = in_ptr(0); const float* g1 = in_ptr(1); const float* w_in = in_ptr(2); const float* g2 = in_ptr(12); const float* w_r = in_ptr(13);
    unsigned char* ws = F.ws;
    LAS unsigned* tile = (LAS unsigned*)(F.lds + wave * 8192);
    const int gw = F.bx * NWAVES + wave, NGW = F.G * NWAVES;
#define P0_LOAD(v, row_) do { const f32x4* xr = (const f32x4*)(x + (size_t)(row_) * D) + lane; _Pragma("unroll") for (int j = 0; j < 8; ++j) v[j] = __builtin_nontemporal_load(xr + 64 * j); } while (0)
#define P0_ROW(v, row_) do { float s = 0.f; \
        _Pragma("unroll") for (int j = 0; j < 8; ++j) s += (v[j][0] * v[j][0] + v[j][1] * v[j][1]) + (v[j][2] * v[j][2] + v[j][3] * v[j][3]); \
        s = wave_sum(s); \
        if (lane == 0) ((float*)(ws + WS_RS1))[row_] = 1.0f / sqrtf(s * (1.0f / D) + EPS); \
        u32x2* o = (u32x2*)((bf16_t*)(ws + WS_XB) + (size_t)(row_) * D) + lane; \
        _Pragma("unroll") for (int j = 0; j < 8; ++j) { u32x2 w; w.x = cvt_pk_bf16(v[j][0], v[j][1]); w.y = cvt_pk_bf16(v[j][2], v[j][3]); o[64 * j] = w; } \
        unsigned* o8 = (unsigned*)(ws + WS_XB8 + (size_t)(row_) * D) + lane; \
        _Pragma("unroll") for (int j = 0; j < 8; ++j) o8[64 * j] = pk4_fp8(v[j][0] * XS, v[j][1] * XS, v[j][2] * XS, v[j][3] * XS); } while (0)
    if (NGW * 8 == T) {
        f32x4 va[8], vb[8];
        P0_LOAD(va, gw);
#pragma unroll
        for (int i = 0; i < 8; i += 2) {
            asm volatile("" ::: "memory"); P0_LOAD(vb, gw + (i + 1) * NGW); asm volatile("" ::: "memory"); P0_ROW(va, gw + i * NGW);
            asm volatile("" ::: "memory"); if (i + 2 < 8) P0_LOAD(va, gw + (i + 2) * NGW); asm volatile("" ::: "memory"); P0_ROW(vb, gw + (i + 1) * NGW);
        }
    } else {
        for (int row = gw; row < T; row += NGW) { f32x4 v[8]; P0_LOAD(v, row); P0_ROW(v, row); }
    }
#undef P0_LOAD
#undef P0_ROW
    for (int idx = (F.bx * NTHREADS + tid); idx < NE * D; idx += F.G * NTHREADS) {
        const int e = idx >> 11, k = idx & 2047; const float val = w_r[k * NE + e] * g2[k];
        const unsigned hi = f2bf(val); const unsigned lo = f2bf(val - bf2f(hi));
        ((bf16_t*)(ws + WS_WRT))[idx] = (bf16_t)hi; ((bf16_t*)(ws + WS_WRT))[NE * D + idx] = (bf16_t)lo;
    }
    constexpr int I_A = (D / 64) * (3072 / 64), I_B = (D / 128) * (4096 / 64);
    for (int r = gw; r < I_A + I_B; r += NGW) {
        if (r < I_A) { const int nb = 3072 / 64, kb = r / nb, n0 = (r % nb) * 64; const int dr = (n0 < 2048) ? map_glu(n0, 1024) : n0;
            tr_item(w_in, NIN, g1, (bf16_t*)(ws + WS_WIN), D, kb * 64, n0, dr, tile, lane); }
        else { const int q = r - I_A, kb = q >> 6, n0 = (q & 63) * 64;
            tr_item8(w_in + 3072, NIN, g1, WSCALE, ws + WS_WIN8, D, kb * 128, n0, map_glu(n0, 2048), tile, lane); }
    }
}
constexpr int Q_CO = (CC / 64) * (D / 64), Q_PO = Q_CO, Q_PW = 4 * 16, Q_O = (D / 64) * (D / 64);
constexpr int Q_W1E = (D / 128) * (4096 / 64), Q_W2E = (DE / 128) * (D / 64);
constexpr int Q_SMALL = Q_CO + Q_O;
__device__ __forceinline__ int q_small_map(int i) { return i < Q_CO ? i : i + Q_PO + Q_PW; }
constexpr int Q_TOTAL = Q_SMALL + NE * (Q_W1E + Q_W2E);
static_assert(Q_SMALL % 2 == 0, "queue chunking");
__device__ __forceinline__ void conv_item(unsigned char* ws, int r, LAS unsigned* tile, int lane) {
    if (r < Q_CO) { const int nb = D / 64, kb = r / nb, n0 = (r % nb) * 64; tr_item(in_ptr(7), D, nullptr, (bf16_t*)(ws + WS_WCO), CC, kb * 64, n0, n0, tile, lane); return; } r -= Q_CO;
    if (r < Q_PO) { const int nb = D / 64, kb = r / nb, n0 = (r % nb) * 64; tr_item(in_ptr(10), D, nullptr, (bf16_t*)(ws + WS_WPO), CC, kb * 64, n0, n0, tile, lane); return; } r -= Q_PO;
    if (r < Q_PW) { const int g = r >> 4, q = r & 15, k0 = (q >> 2) * 64, j0 = (q & 3) * 64;
        const float* pw = in_ptr(8) + (size_t)g * 65536; const float* ps = in_ptr(9) + g * 256; bf16_t* o = (bf16_t*)(ws + WS_WPW) + (size_t)g * 65536;
        const int jj = j0 + 4 * (lane & 15); const f32x4 sc = *(const f32x4*)(ps + jj);
#pragma unroll
        for (int i = 0; i < 16; ++i) { const int k = k0 + 4 * i + (lane >> 4); const f32x4 v = *(const f32x4*)(pw + k * 256 + jj) * sc; u32x2 w; w.x = cvt_pk_bf16(v[0], v[1]); w.y = cvt_pk_bf16(v[2], v[3]); *(u32x2*)(o + k * 256 + jj) = w; }
        return; } r -= Q_PW;
    if (r < Q_O) { const int nb = D / 64, kb = r / nb, n0 = (r % nb) * 64; tr_item(in_ptr(11), D, nullptr, (bf16_t*)(ws + WS_WO), D, kb * 64, n0, n0, tile, lane); return; } r -= Q_O;
    if (r < NE * Q_W1E) { const int e = r / Q_W1E, q = r % Q_W1E; const int nb = 4096 / 64, kb = q / nb, n0 = (q % nb) * 64;
        tr_item8(in_ptr(15) + (size_t)e * D * 4096, 4096, nullptr, WSCALE, ws + WS_W1 + (size_t)e * 4096 * D, D, kb * 128, n0, map_glu(n0, 2048), tile, lane); return; } r -= NE * Q_W1E;
    { const int e = r / Q_W2E, q = r % Q_W2E; const int nb = D / 64, kb = q / nb, n0 = (q % nb) * 64;
        tr_item8(in_ptr(17) + (size_t)e * DE * D, D, nullptr, WSCALE, ws + WS_W2 + (size_t)e * D * DE, DE, kb * 128, n0, n0, tile, lane); }
}
__device__ __forceinline__ void p0_pool_weights(const Frame& F) {
    PHASE_IDS();
    LAS unsigned* tile = (LAS unsigned*)(F.lds + wave * 8192);
    for (int r = F.bx * NWAVES + wave; r < Q_PO + Q_PW; r += F.G * NWAVES) conv_item(F.ws, Q_CO + r, tile, lane);
}
constexpr int QP_W1E = (D / 128) * (4096 / 128), QP_W2E = (DE / 128) * (D / 128);
constexpr int QC_SMALL = Q_SMALL / 2, QC_TOTAL = QC_SMALL + NE * (QP_W1E + QP_W2E);
struct QDesc { const float* W; unsigned char* WT; int N, ldk, k0, n0, drow0; };
__device__ __forceinline__ QDesc q_decode(unsigned char* ws, int r, const float* w1, const float* w2) {
    QDesc d;
    if (r < NE * QP_W1E) { const int e = r / QP_W1E, q = r % QP_W1E, kb = q >> 5, n0 = (q & 31) * 128;
        d.W = w1 + (size_t)e * D * 4096; d.WT = ws + WS_W1 + (size_t)e * 4096 * D; d.N = 4096; d.ldk = D; d.k0 = kb * 128; d.n0 = n0; d.drow0 = map_glu(n0, 2048); }
    else { r -= NE * QP_W1E; const int e = r / QP_W2E, q = r % QP_W2E, kb = q >> 4, n0 = (q & 15) * 128;
        d.W = w2 + (size_t)e * DE * D; d.WT = ws + WS_W2 + (size_t)e * D * DE; d.N = D; d.ldk = DE; d.k0 = kb * 128; d.n0 = n0; d.drow0 = n0; }
    return d;
}
__device__ __forceinline__ const float* q_base(const QDesc& d, int lane) { return d.W + (size_t)(d.k0 + 4 * (lane >> 5)) * d.N + d.n0 + 4 * (lane & 31); }
template <int E> __device__ __forceinline__ void q_load(f32x4 (&v)[8], const float* pb, int N) {
#pragma unroll
    for (int i = 0; i < 8; ++i) { const float* p = pb + (size_t)((16 * E + 8 * (i >> 2) + (i & 3)) * N);
        asm volatile("global_load_dwordx4 %0, %1, off nt" : "=v"(v[i]) : "v"(p) : "memory"); }
}
template <int N> __device__ __forceinline__ void q_wait(f32x4 (&v)[8]) {
    asm volatile("s_waitcnt vmcnt(%8)" : "+v"(v[0]), "+v"(v[1]), "+v"(v[2]), "+v"(v[3]), "+v"(v[4]), "+v"(v[5]), "+v"(v[6]), "+v"(v[7]) : "n"(N) : "memory");
}
template <int E> __device__ __forceinline__ void q_proc(const f32x4 (&v)[8], LAS unsigned* tile, int lane) {
    const int kq = lane >> 5, nq = lane & 31;
#pragma unroll
    for (int h = 0; h < 2; ++h) {
#pragma unroll
        for (int j = 0; j < 4; ++j) tile[(4 * nq + j) * 32 + ((E ^ (nq & 7)) * 4) + 2 * h + kq] = pk4_fp8(v[4 * h][j] * WSCALE, v[4 * h + 1][j] * WSCALE, v[4 * h + 2][j] * WSCALE, v[4 * h + 3][j] * WSCALE); }
}
__device__ __forceinline__ void q_readout(const QDesc& d, LAS unsigned* tile, int lane) {
    LDS_WAIT();
    const int nr = lane >> 3, kc = lane & 7;
#pragma unroll
    for (int ir = 0; ir < 16; ++ir) { const int n = 8 * ir + nr; const u32x4 o = *(const LAS u32x4*)(tile + n * 32 + ((kc ^ ((n >> 2) & 7)) * 4));
        __builtin_nontemporal_store(o, (u32x4*)(d.WT + (size_t)(d.drow0 + n) * d.ldk + d.k0 + 16 * kc)); }
    LDS_WAIT();
}
constexpr int QG_SMALL = QC_SMALL / 8, QG_TOTAL = QC_TOTAL / 8;
static_assert(QC_SMALL % 8 == 0 && QC_TOTAL % 8 == 0, "queue grouping");
__device__ __forceinline__ void conv_queue(const Frame& F) {
    PHASE_IDS();
    unsigned* qhead = (unsigned*)(F.ws + WS_CTL) + CW_QHEAD;
    LAS unsigned* tile = (LAS unsigned*)(F.lds + wave * 16384);
    volatile LAS int* slot = (volatile LAS int*)(F.lds + L_UNITS);
    int it = 0;
    if (tid == 0) slot[0] = (int)__hip_atomic_fetch_add(qhead, 1u, __ATOMIC_RELAXED, __HIP_MEMORY_SCOPE_AGENT);
    __syncthreads();
    int g = __builtin_amdgcn_readfirstlane(slot[0]);
    while (g < QG_SMALL) {
        if (tid == 0) slot[(it + 1) & 1] = (int)__hip_atomic_fetch_add(qhead, 1u, __ATOMIC_RELAXED, __HIP_MEMORY_SCOPE_AGENT);
        const int c = 8 * g + wave; conv_item(F.ws, q_small_map(2 * c), tile, lane); conv_item(F.ws, q_small_map(2 * c + 1), tile, lane);
        __syncthreads();
        g = __builtin_amdgcn_readfirstlane(slot[(it + 1) & 1]); ++it;
    }
    if (g >= QG_TOTAL) return;
    const float* w1 = in_ptr(15); const float* w2 = in_ptr(17);
    if (tid == 0) slot[(it + 1) & 1] = (int)__hip_atomic_fetch_add(qhead, 1u, __ATOMIC_RELAXED, __HIP_MEMORY_SCOPE_AGENT);
    __syncthreads();
    int gnext = __builtin_amdgcn_readfirstlane(slot[(it + 1) & 1]); ++it;
    QDesc d = q_decode(F.ws, 8 * g + wave - QC_SMALL, w1, w2);
    f32x4 v0[8], v1[8], v2[8], v3[8];
    unsigned pend2 = 0u;
    const float* pd = q_base(d, lane);
    q_load<0>(v0, pd, d.N); q_load<1>(v1, pd, d.N); q_load<2>(v2, pd, d.N);
#define Q_FENCE() do { asm volatile("" ::: "memory"); __builtin_amdgcn_sched_barrier(0); } while (0)
    for (;;) {
        const int nr = (gnext < QG_TOTAL) ? 8 * gnext + wave : -1;
        if (nr >= 0) { if (tid == 0) asm volatile("global_atomic_add %0, %1, %2, %3 sc0" : "=v"(pend2) : "v"(0), "v"(1), "s"(qhead) : "memory"); }
        const QDesc dn = (nr >= 0) ? q_decode(F.ws, nr - QC_SMALL, w1, w2) : d;
        const float* pn = q_base(dn, lane);
        Q_FENCE(); q_load<3>(v3, pd, d.N);  Q_FENCE(); q_wait<24>(v0); q_proc<0>(v0, tile, lane);
        Q_FENCE(); q_load<4>(v0, pd, d.N);  Q_FENCE(); q_wait<24>(v1); q_proc<1>(v1, tile, lane);
        Q_FENCE(); q_load<5>(v1, pd, d.N);  Q_FENCE(); q_wait<24>(v2); q_proc<2>(v2, tile, lane);
        Q_FENCE(); q_load<6>(v2, pd, d.N);  Q_FENCE(); q_wait<24>(v3); q_proc<3>(v3, tile, lane);
        Q_FENCE(); q_load<7>(v3, pd, d.N);  Q_FENCE(); q_wait<24>(v0); q_proc<4>(v0, tile, lane);
        Q_FENCE(); q_load<0>(v0, pn, dn.N); Q_FENCE(); q_wait<24>(v1); q_proc<5>(v1, tile, lane);
        Q_FENCE(); q_load<1>(v1, pn, dn.N); Q_FENCE(); q_wait<24>(v2); q_proc<6>(v2, tile, lane);
        Q_FENCE(); q_load<2>(v2, pn, dn.N); Q_FENCE(); q_wait<24>(v3); q_proc<7>(v3, tile, lane);
        Q_FENCE(); q_readout(d, tile, lane); Q_FENCE();
        if (nr < 0) break;
        if (tid == 0) { asm volatile("s_waitcnt vmcnt(24)" : "+v"(pend2) :: "memory"); slot[(it + 1) & 1] = (int)pend2; }
        LDS_WAIT(); Q_FENCE(); __builtin_amdgcn_s_barrier(); Q_FENCE();
        gnext = __builtin_amdgcn_readfirstlane(slot[(it + 1) & 1]); ++it;
        d = dn; pd = pn;
    }
    asm volatile("s_waitcnt vmcnt(0)" ::: "memory");
#undef Q_FENCE
}

template <int W> __device__ __forceinline__ void pool_item(const unsigned (&pr)[31], bf16_t* DP, int t0, int s0, int c0) {
#pragma unroll
    for (int o = 0; o < 16; ++o) { float a0 = 0.f, a1 = 0.f;
#pragma unroll
        for (int j = 0; j < W; ++j) { a0 += bflo(pr[15 + o - j]); a1 += bfhi(pr[15 + o - j]); }
        const int pos = s0 + o + 1; const float inv = 1.0f / (float)(pos < W ? pos : W);
        *(unsigned*)(DP + (size_t)(t0 + o) * CC + c0) = cvt_pk_bf16(a0 * inv - bflo(pr[15 + o]), a1 * inv - bfhi(pr[15 + o])); }
}
__device__ __forceinline__ void p2_conv_pool(const Frame& F, const Args& a) {
    PHASE_IDS();
    const float* conv_w = in_ptr(3); const float* conv_b = in_ptr(4); const float* ln_g = in_ptr(5); const float* ln_b = in_ptr(6);
    const bf16_t* U = (const bf16_t*)(F.ws + WS_U); const bf16_t* P = (const bf16_t*)(F.ws + WS_P);
    bf16_t* AC = (bf16_t*)(F.ws + WS_AC); bf16_t* DP = (bf16_t*)(F.ws + WS_DP);
    const int c0 = 2 * tid;
    f32x2 wv[31];
#pragma unroll
    for (int j = 0; j < 31; ++j) wv[j] = *(const f32x2*)(conv_w + j * CC + c0);
    const f32x2 cb = *(const f32x2*)(conv_b + c0), lg = *(const f32x2*)(ln_g + c0), lb = *(const f32x2*)(ln_b + c0);
    const int gi = wave >> 1;
    int par = 0;
    unsigned pr[31], ur[46], ur2[46];
#define P2_LOADP(PR, it) do { const int t0_ = (it) * 16, s0_ = t0_ & (SEQ - 1); \
        _Pragma("unroll") for (int r = 0; r < 31; ++r) { PR[r] = 0u; if (s0_ - 15 + r >= 0) PR[r] = *(const unsigned*)(P + (size_t)(t0_ - 15 + r) * CC + c0); } } while (0)
#define P2_LOADU(UR, it) do { const int t0_ = (it) * 16, s0_ = t0_ & (SEQ - 1); \
        _Pragma("unroll") for (int r = 0; r < 46; ++r) { UR[r] = 0u; if (s0_ - 30 + r >= 0) UR[r] = *(const unsigned*)(U + (size_t)(t0_ - 30 + r) * CC + c0); } } while (0)
    if (F.bx < T / 16) P2_LOADU(ur, F.bx);
    for (int item = F.bx; item < T / 16; item += F.G, par ^= 1) {
        LAS float* red = (LAS float*)(F.lds + par * 65536);
        LAS float* tot = (LAS float*)(F.lds + L_TBL + par * 256);
        const int t0 = item * 16, s0 = t0 & (SEQ - 1);
        const int nitem = (item + F.G < T / 16) ? item + F.G : item;
        P2_LOADP(pr, item); P2_LOADU(ur2, nitem);
        asm volatile("" ::: "memory");
        if (gi == 0) pool_item<2>(pr, DP, t0, s0, c0); else if (gi == 1) pool_item<4>(pr, DP, t0, s0, c0); else if (gi == 2) pool_item<8>(pr, DP, t0, s0, c0); else pool_item<16>(pr, DP, t0, s0, c0);
        f32x2 av[16];
#pragma unroll
        for (int o = 0; o < 16; ++o) av[o] = cb;
#pragma unroll
        for (int r = 0; r < 46; ++r) {
            const f32x2 uv = (f32x2){bflo(ur[r]), bfhi(ur[r])};
#pragma unroll
            for (int o = 0; o < 16; ++o) { const int j = r - o; if (j >= 0 && j <= 30) av[o] = __builtin_elementwise_fma(wv[j], uv, av[o]); }
        }
#pragma unroll
        for (int o = 0; o < 16; ++o) { red[o * 512 + tid] = av[o][0] + av[o][1]; red[(16 + o) * 512 + tid] = av[o][0] * av[o][0] + av[o][1] * av[o][1]; }
        __syncthreads();
#pragma unroll
        for (int q = 0; q < 4; ++q) { const int row = wave * 4 + q; float s = 0.f;
#pragma unroll
            for (int i = 0; i < 8; ++i) s += red[row * 512 + lane + 64 * i];
            s = wave_sum(s); if (lane == 0) tot[row] = s; }
        __syncthreads();
#pragma unroll
        for (int o = 0; o < 16; ++o) { const float mean = tot[o] * (1.0f / CC), var = tot[16 + o] * (1.0f / CC) - mean * mean; const float rstd = 1.0f / sqrtf(fmaxf(var, 0.f) + EPS);
            const float y0 = (av[o][0] - mean) * rstd * lg[0] + lb[0], y1 = (av[o][1] - mean) * rstd * lg[1] + lb[1];
            *(unsigned*)(AC + (size_t)(t0 + o) * CC + c0) = cvt_pk_bf16(y0 * sigmoidf_(y0), y1 * sigmoidf_(y1)); }
        asm volatile("" ::: "memory");
#pragma unroll
        for (int r = 0; r < 46; ++r) ur[r] = ur2[r];
    }
#undef P2_LOADP
#undef P2_LOADU
    __syncthreads();
}

__device__ __forceinline__ void p6_router(const Frame& F, const Args& a) {
    PHASE_IDS();
    const float* b_r = in_ptr(14);
    const bf16_t* H = (const bf16_t*)(F.ws + WS_H); const float* SSQP = (const float*)(F.ws + WS_SSQP);
    const bf16_t* WH = (const bf16_t*)(F.ws + WS_WRT); const bf16_t* WL = WH + NE * D;
    int* ltok = (int*)(F.ws + WS_LTOK); float* lgate = (float*)(F.ws + WS_LGATE); float* lrs = (float*)(F.ws + WS_LRS); int* slotref = (int*)(F.ws + WS_SLOTREF);
    unsigned* cnt = (unsigned*)(F.ws + WS_CTL) + CW_CNT;
    const int fr = lane & 15, fq = lane >> 4;
    const int grp = wave & 3, kh = wave >> 2;
    LAS float* lg = (LAS float*)(F.lds + grp * 4096);
    LAS float* part = (LAS float*)(F.lds + 16384 + grp * 2048);
    LAS unsigned* lcnt = (LAS unsigned*)(F.lds + 32768);
    LAS unsigned* gbase = (LAS unsigned*)(F.lds + 32768 + 128);
    for (int item = F.bx; item < T / 64; item += F.G) {
        const int t0 = item * 64 + grp * 16;
        const bf16_t* hrow = H + (size_t)(t0 + fr) * D + 8 * fq + kh * 1024;
        const bf16_t* wh = WH + (size_t)fr * D + 8 * fq + kh * 1024; const bf16_t* wl = WL + (size_t)fr * D + 8 * fq + kh * 1024;
        f32x4 acc0 = (f32x4){0.f, 0.f, 0.f, 0.f}, acc1 = acc0;
        bf16x8 hb[4][2], ah[4][2], bh[4][2], al[4][2], bl[4][2];
        const bf16_t* pA = wh; const bf16_t* pB = wh + 16 * D; const bf16_t* pC = wl; const bf16_t* pD = wl + 16 * D; const bf16_t* pH = hrow;
        asm volatile("" : "+v"(pA), "+v"(pB), "+v"(pC), "+v"(pD), "+v"(pH));
#define R_LOAD(buf, s0) do { _Pragma("unroll") for (int i = 0; i < 2; ++i) { const int o = 32 * ((s0) + i); hb[buf][i] = *(const bf16x8*)(pH + o); ah[buf][i] = *(const bf16x8*)(pA + o); bh[buf][i] = *(const bf16x8*)(pB + o); \
            al[buf][i] = *(const bf16x8*)(pC + o); bl[buf][i] = *(const bf16x8*)(pD + o); } } while (0)
#define R_FENCE() do { asm volatile("" ::: "memory"); __builtin_amdgcn_sched_barrier(0); } while (0)
        R_LOAD(0, 0); R_LOAD(1, 2); R_LOAD(2, 4); R_FENCE();
#pragma unroll
        for (int b = 0; b < 16; ++b) {
            if (b + 3 < 16) R_LOAD((b + 3) & 3, 2 * (b + 3));
            R_FENCE();
#pragma unroll
            for (int i = 0; i < 2; ++i) {
                acc0 = __builtin_amdgcn_mfma_f32_16x16x32_bf16(ah[b & 3][i], hb[b & 3][i], acc0, 0, 0, 0); acc0 = __builtin_amdgcn_mfma_f32_16x16x32_bf16(al[b & 3][i], hb[b & 3][i], acc0, 0, 0, 0);
                acc1 = __builtin_amdgcn_mfma_f32_16x16x32_bf16(bh[b & 3][i], hb[b & 3][i], acc1, 0, 0, 0); acc1 = __builtin_amdgcn_mfma_f32_16x16x32_bf16(bl[b & 3][i], hb[b & 3][i], acc1, 0, 0, 0);
            }
            R_FENCE();
        }
#undef R_LOAD
#undef R_FENCE
        if (kh == 1) { *(LAS f32x4*)(part + lane * 8) = acc0; *(LAS f32x4*)(part + lane * 8 + 4) = acc1; }
        if (tid < NE) lcnt[tid] = 0u;
        __syncthreads();
        float p[4] = {0.f, 0.f, 0.f, 0.f}; int ti[4] = {0, 0, 0, 0}; unsigned lpos[4] = {0u, 0u, 0u, 0u}; float inv = 0.f, rs_tok = 0.f;
        if (kh == 0) {
        acc0 = acc0 + *(const LAS f32x4*)(part + lane * 8); acc1 = acc1 + *(const LAS f32x4*)(part + lane * 8 + 4);
        float ss = 0.f;
#pragma unroll
        for (int i = 0; i < 8; ++i) { const f32x4 pp = *(const f32x4*)(SSQP + (size_t)(t0 + fr) * 32 + 4 * i); ss += (pp[0] + pp[1]) + (pp[2] + pp[3]); }
        const float rs = 1.0f / sqrtf(ss * (1.0f / D) + EPS);
#pragma unroll
        for (int j = 0; j < 4; ++j) { lg[fr * 33 + 4 * fq + j] = acc0[j] * rs + b_r[4 * fq + j]; lg[fr * 33 + 16 + 4 * fq + j] = acc1[j] * rs + b_r[16 + 4 * fq + j]; }
        LDS_WAIT(); __builtin_amdgcn_wave_barrier();
        if (lane < 16) {
            float v[32];
#pragma unroll
            for (int e = 0; e < 32; ++e) v[e] = lg[lane * 33 + e];
            float tv[4];
#pragma unroll
            for (int k = 0; k < 4; ++k) { float best = -3.0e38f; int bi = 0;
#pragma unroll
                for (int e = 0; e < 32; ++e) if (v[e] > best) { best = v[e]; bi = e; }
                tv[k] = best; ti[k] = bi;
#pragma unroll
                for (int e = 0; e < 32; ++e) v[e] = (e == bi) ? -3.0e38f : v[e]; }
            float sum = 0.f;
#pragma unroll
            for (int k = 0; k < 4; ++k) { p[k] = __expf(tv[k] - tv[0]); sum += p[k]; }
            inv = 1.0f / sum; rs_tok = rs;
#pragma unroll
            for (int k = 0; k < 4; ++k) lpos[k] = __hip_atomic_fetch_add(lcnt + ti[k], 1u, __ATOMIC_RELAXED, __HIP_MEMORY_SCOPE_WORKGROUP);
        }
        }
        __syncthreads();
        if (tid < NE) { const unsigned c = lcnt[tid]; gbase[tid] = c ? __hip_atomic_fetch_add(cnt + 64 * tid, c, __ATOMIC_RELAXED, __HIP_MEMORY_SCOPE_AGENT) : 0u; }
        __syncthreads();
        if (kh == 0 && lane < 16) { const int tok = t0 + lane;
#pragma unroll
            for (int k = 0; k < 4; ++k) { const int e = ti[k]; const unsigned pos = gbase[e] + lpos[k];
                ltok[e * LCAP + pos] = tok; lgate[e * LCAP + pos] = p[k] * inv; lrs[e * LCAP + pos] = rs_tok; slotref[tok * 4 + k] = (e << 16) | (int)pos; }
        }
        __syncthreads();
    }
}

__device__ __forceinline__ void moe_prepare(const Frame& F) {
    PHASE_IDS();
    unsigned* cnt = (unsigned*)(F.ws + WS_CTL) + CW_CNT;
    LAS int* lc = (LAS int*)(F.lds + L_CNT); LAS int* lb = (LAS int*)(F.lds + L_BASE); LAS int* ln = (LAS int*)(F.lds + L_NRT);
    __syncthreads();
    if (tid < NE) { const int c = (int)__hip_atomic_load(cnt + 64 * tid, __ATOMIC_RELAXED, __HIP_MEMORY_SCOPE_AGENT); lc[tid] = c; ln[tid] = (c + 255) >> 8; }
    __syncthreads();
    if (tid < NE) { int b = 0; for (int e = 0; e < NE; ++e) { const int v = ln[e]; b += (e < tid) ? v : 0; } lb[tid] = b * 256; }
    __syncthreads();
}
template <int NCB, int CPB  , bool GLOBAL> __device__ __forceinline__ void moe_build_units(const Frame& F) {
    PHASE_IDS();
    LAS int* ln = (LAS int*)(F.lds + L_NRT); LAS int* lu = (LAS int*)(F.lds + L_UNITS); LAS int* lnu = (LAS int*)(F.lds + L_NU);
    constexpr int EM = 8 / NCB;
    if (GLOBAL && F.G == 256) {
        const int j = (F.bx % 8) * 32 + F.bx / 8;
        int code = 0; bool has = false;
        if (tid < NE * NCB) { const int e = tid / NCB, cb = tid % NCB; int pre = 0;
            for (int e2 = 0; e2 < NE; ++e2) { const int v = ln[e2]; pre += (e2 < e) ? v : 0; }
            const int nrt = ln[e], n = nrt * CPB, pos = (pre * NCB + cb * nrt) * CPB, q = (j - pos) & 255;
            has = q < n; code = (e << 16) | ((q / CPB) << 8) | (cb * CPB + q % CPB); }
        const unsigned long long m = __ballot(has);
        if (tid == 0) lnu[1] = __popcll(m);
        __syncthreads();
        if (tid < NE * NCB) { const int off = (wave == 1) ? lnu[1] : 0;
            if (has) lu[off + __popcll(m & ((1ull << lane) - 1ull))] = code;
            if (tid == 64) lnu[0] = off + __popcll(m); }
        __syncthreads();
        return;
    }
    if (tid == 0) {
        const int NS = (F.G % 8 == 0 && !GLOBAL) ? 8 : 1; const int x = F.bx % NS;
        const int j = GLOBAL ? ((F.G % 8 == 0) ? (F.bx % 8) * (F.G / 8) + F.bx / 8 : F.bx) : F.bx / NS, nj = F.G / NS;
        int p = 0, nu = 0;
        for (int e = 0; e < NE; ++e) {
            for (int cb = 0; cb < NCB; ++cb) {
                if (NS == 8) { if ((e % EM) != (x % EM)) continue; if (cb != (((e / EM) + (x / EM)) % NCB)) continue; }
                const int n = ln[e] * CPB;
                int q = (j - (p % nj) + nj) % nj;
                for (; q < n; q += nj) { const int rt = q / CPB, c4 = q % CPB; if (nu < 256) lu[nu++] = (e << 16) | (rt << 8) | (cb * CPB + c4); }
                p += n;
            }
        }
        lnu[0] = nu;
    }
    __syncthreads();
}

__device__ __forceinline__ void p9_combine(const Frame& F, const Args& a) {
    PHASE_IDS();
    const float* gf = in_ptr(19); const bf16_t* H = (const bf16_t*)(F.ws + WS_H); const unsigned char* Y = (const unsigned char*)(F.ws + WS_Y); const int* slotref = (const int*)(F.ws + WS_SLOTREF);
    const LAS int* lb = (const LAS int*)(F.lds + L_BASE);
    const int gw = F.bx * NWAVES + wave, NGW = F.G * NWAVES;
    float* out = out_ptr();
    f32x4 gv[8];
#pragma unroll
    for (int q = 0; q < 8; ++q) gv[q] = ((const f32x4*)gf)[lane + 64 * q];
#define P9_ISSUE(hb, yb, tok_, sr_) do { _Pragma("unroll") for (int q = 0; q < 8; ++q) hb[q] = ((const u32x2*)(H + (size_t)(tok_) * D))[lane + 64 * q]; \
        _Pragma("unroll") for (int k = 0; k < 4; ++k) { const int sr = (sr_)[k]; const int slot = lb[sr >> 16] + (sr & 0xffff); const unsigned* yr = (const unsigned*)(Y + (size_t)slot * D) + lane; \
            _Pragma("unroll") for (int q = 0; q < 8; ++q) yb[k][q] = yr[64 * q]; } } while (0)
#define P9_FIN(hb, yb, tok_) do { f32x4 v[8]; \
        _Pragma("unroll") for (int q = 0; q < 8; ++q) v[q] = (f32x4){bflo(hb[q].x), bfhi(hb[q].x), bflo(hb[q].y), bfhi(hb[q].y)}; \
        _Pragma("unroll") for (int k = 0; k < 4; ++k) _Pragma("unroll") for (int q = 0; q < 8; ++q) { const unsigned w = yb[k][q]; const f32x2 lo = __builtin_amdgcn_cvt_pk_f32_fp8((int)w, false), hi = __builtin_amdgcn_cvt_pk_f32_fp8((int)w, true); \
            v[q][0] += lo[0] * (1.0f / YSCALE); v[q][1] += lo[1] * (1.0f / YSCALE); v[q][2] += hi[0] * (1.0f / YSCALE); v[q][3] += hi[1] * (1.0f / YSCALE); } \
        float s = 0.f; \
        _Pragma("unroll") for (int q = 0; q < 8; ++q) s += (v[q][0] * v[q][0] + v[q][1] * v[q][1]) + (v[q][2] * v[q][2] + v[q][3] * v[q][3]); \
        s = wave_sum(s); const float rs = 1.0f / sqrtf(s * (1.0f / D) + EPS); \
        _Pragma("unroll") for (int q = 0; q < 8; ++q) __builtin_nontemporal_store(v[q] * rs * gv[q], (f32x4*)(out + (size_t)(tok_) * D) + lane + 64 * q); } while (0)
#define P9_FENCE() asm volatile("" ::: "memory")
    if (NGW * 8 == T) {
        i32x4 srs[8];
#pragma unroll
        for (int i = 0; i < 8; ++i) srs[i] = *(const i32x4*)(slotref + (gw + i * NGW) * 4);
        u32x2 hA[8], hB[8]; unsigned yA[4][8], yB[4][8];
        P9_ISSUE(hA, yA, gw, srs[0]);
#pragma unroll
        for (int i = 0; i < 8; i += 2) {
            P9_FENCE(); P9_ISSUE(hB, yB, gw + (i + 1) * NGW, srs[i + 1]); P9_FENCE(); P9_FIN(hA, yA, gw + i * NGW);
            P9_FENCE(); if (i + 2 < 8) P9_ISSUE(hA, yA, gw + (i + 2) * NGW, srs[i + 2]); P9_FENCE(); P9_FIN(hB, yB, gw + (i + 1) * NGW);
        }
        return;
    }
#undef P9_ISSUE
#undef P9_FIN
#undef P9_FENCE
    for (int tok = gw; tok < T; tok += NGW) {
        f32x4 v[8];
#pragma unroll
        for (int q = 0; q < 8; ++q) { const u32x2 w = ((const u32x2*)(H + (size_t)tok * D))[lane + 64 * q]; v[q] = (f32x4){bflo(w.x), bfhi(w.x), bflo(w.y), bfhi(w.y)}; }
        const i32x4 sr4 = *(const i32x4*)(slotref + tok * 4);
#pragma unroll
        for (int k = 0; k < 4; ++k) { const int sr = sr4[k]; const int slot = lb[sr >> 16] + (sr & 0xffff);
            const unsigned* yr = (const unsigned*)(Y + (size_t)slot * D) + lane;
#pragma unroll
            for (int q = 0; q < 8; ++q) { const unsigned w = yr[64 * q]; const f32x2 lo = __builtin_amdgcn_cvt_pk_f32_fp8((int)w, false), hi = __builtin_amdgcn_cvt_pk_f32_fp8((int)w, true);
                v[q][0] += lo[0] * (1.0f / YSCALE); v[q][1] += lo[1] * (1.0f / YSCALE); v[q][2] += hi[0] * (1.0f / YSCALE); v[q][3] += hi[1] * (1.0f / YSCALE); } }
        float s = 0.f;
#pragma unroll
        for (int q = 0; q < 8; ++q) s += (v[q][0] * v[q][0] + v[q][1] * v[q][1]) + (v[q][2] * v[q][2] + v[q][3] * v[q][3]);
        s = wave_sum(s); const float rs = 1.0f / sqrtf(s * (1.0f / D) + EPS);
#pragma unroll
        for (int q = 0; q < 8; ++q) __builtin_nontemporal_store(v[q] * rs * gv[q], (f32x4*)(out + (size_t)tok * D) + lane + 64 * q);
    }
}

constexpr int NPH = 10;
__global__ void __launch_bounds__(NTHREADS, 2) fwd(Args args) {
    extern __shared__ __attribute__((aligned(16))) unsigned char lds_raw[];
    Frame F; F.lds = (LAS unsigned char*)lds_raw; F.ws = args.ws;
    F.G = gridDim.x; F.bx = blockIdx.x;
    { const int t0 = tid_opaque(); for (int u = t0; u < (LDS_BYTES - STAGE_BYTES) / 4; u += NTHREADS) ((LAS unsigned*)(F.lds + STAGE_BYTES))[u] = 0u; }
    __syncthreads();
    unsigned* ctl = (unsigned*)(args.ws + WS_CTL);
    XcdBarrier bar; bar.bar = ctl + CW_BAR; bar.x = 0; bar.st = nullptr;
    if (N_LAUNCHES == 1) bar = xcd_barrier_post(ctl + CW_BAR, (volatile LAS unsigned*)(F.lds + L_MISC) + 8);
    const int lo = args.ph_lo, hi = args.ph_hi;
#define IN(k) (lo <= (k) && (k) < hi)
#define SEAM(k) do { if (IN(k) && IN((k) + 1)) xcd_barrier(bar); } while (0)
    unsigned char* ws = args.ws;

    if (IN(0)) { p0_pre(F); p0_pool_weights(F); } SEAM(0);

    if (IN(1)) {
        const bool split = (F.G == 256);
        const int ggemm = split ? 160 : F.G;
        if (F.bx < ggemm) {
            { DenseSched S; S.A = (const char*)(ws + WS_XB); S.B = (const char*)(ws + WS_WIN); S.lda = D; S.ldb = D; S.G = ggemm; S.c = F.bx; S.to.init(T, 3072, 4);
              EpiWin E{(bf16_t*)(ws + WS_U), (bf16_t*)(ws + WS_P), (const float*)(ws + WS_RS1), F.lds};
              gemm_phase<EpiWin, DenseSched, false, false>(F.lds, D * 2, D * 2, S, E); }
            { DenseSched8 S; S.A = (const char*)(ws + WS_XB8); S.B = (const char*)(ws + WS_WIN8); S.lda = D; S.ldb = D; S.G = ggemm; S.c = ggemm - 1 - F.bx; S.to.init(T, 4096, 4);
              EpiGate E{(bf16_t*)(ws + WS_G), (const float*)(ws + WS_RS1), F.lds};
              gemm_phase<EpiGate, DenseSched8, false, true>(F.lds, D, D, S, E); }
            if (split && F.bx >= 8 && F.bx < 40) {
                PoolSched S2; S2.A = (const char*)(ws + WS_WPO); S2.B = (const char*)(ws + WS_WPW); S2.G = 32; S2.c = F.bx - 8;
                EpiPool E2{(bf16_t*)(ws + WS_YP)};
                gemm_phase<EpiPool, PoolSched, false, false>(F.lds, 256 * 2, 256 * 2, S2, E2);
            }
        }
        conv_queue(F);
    } SEAM(1);


    if (IN(2)) {
        if (F.G != 256) { PoolSched S; S.A = (const char*)(ws + WS_WPO); S.B = (const char*)(ws + WS_WPW); S.G = F.G; S.c = F.bx;
          EpiPool E{(bf16_t*)(ws + WS_YP)};
          gemm_phase<EpiPool, PoolSched, false, false>(F.lds, 256 * 2, 256 * 2, S, E); }
        __syncthreads();
        p2_conv_pool(F, args);
    } SEAM(2);

    if (IN(4)) {
        MergeSched S; S.A0 = (const char*)(ws + WS_AC); S.A1 = (const char*)(ws + WS_DP); S.B0 = (const char*)(ws + WS_WCO); S.B1 = (const char*)(ws + WS_YP); S.G = F.G; S.c = F.bx; S.to.init(T, D);
        EpiMerge E{(bf16_t*)(ws + WS_MG), (const bf16_t*)(ws + WS_G)};
        gemm_phase<EpiMerge, MergeSched, false, false>(F.lds, CC * 2, CC * 2, S, E);
    } SEAM(4);

    if (IN(5)) {
        DenseSched S; S.A = (const char*)(ws + WS_MG); S.B = (const char*)(ws + WS_WO); S.lda = D; S.ldb = D; S.G = F.G; S.c = F.bx; S.to.init(T, D);
        EpiWo E{(const bf16_t*)(ws + WS_XB), (bf16_t*)(ws + WS_H), (unsigned char*)(ws + WS_HB), (float*)(ws + WS_SSQP), in_ptr(12)};
        gemm_phase<EpiWo, DenseSched, false, false>(F.lds, D * 2, D * 2, S, E);
    } SEAM(5);

    if (IN(6)) { p6_router(F, args); } SEAM(6);

    if (IN(7)) {
        moe_prepare(F); moe_build_units<4, 4, true>(F);
        MoeSched S; S.lds = F.lds; S.A = (const char*)(ws + WS_HB); S.B = (const char*)(ws + WS_W1); S.ltok = (const int*)(ws + WS_LTOK); S.gather = 1; S.nrows_w = 4096;
        EpiMoe1 E{(unsigned char*)(ws + WS_ACT), in_ptr(16), (const float*)(ws + WS_LRS), F.lds};
        gemm_phase<EpiMoe1, MoeSched, true, true>(F.lds, D, D, S, E);
    } SEAM(7);

    if (IN(8)) {
        if (!IN(7)) moe_prepare(F);
        moe_build_units<4, 2, true>(F);
        MoeSched S; S.lds = F.lds; S.A = (const char*)(ws + WS_ACT); S.B = (const char*)(ws + WS_W2); S.ltok = nullptr; S.gather = 0; S.nrows_w = 2048;
        EpiMoe2 E{(unsigned char*)(ws + WS_Y), in_ptr(18), (const float*)(ws + WS_LGATE), F.lds};
        gemm_phase<EpiMoe2, MoeSched, false, true>(F.lds, DE, DE, S, E);
    } SEAM(8);

    if (IN(9)) { if (!IN(7)) moe_prepare(F); p9_combine(F, args); }
#undef IN
#undef SEAM
}

extern "C" void kernel_launch(void* const* d_in, const int* in_sizes, int n_in, void* d_out, int out_size, void* d_ws, size_t ws_size, hipStream_t stream) {
    static int grid = 0;
    if (grid == 0) {
        if (n_in != 20 || in_sizes[0] != T * D || out_size != T * D || ws_size < WS_END) { fprintf(stderr, "kernel_launch: unexpected shapes (n_in %d, in0 %d, out %d, ws %zu)\n", n_in, n_in > 0 ? in_sizes[0] : -1, out_size, ws_size); grid = -1; return; }
        int dev = 0, cus = 0, per_cu = 0;
        if (hipGetDevice(&dev) != hipSuccess || hipDeviceGetAttribute(&cus, hipDeviceAttributeMultiprocessorCount, dev) != hipSuccess) { grid = -1; return; }
        if (hipFuncSetAttribute((const void*)fwd, hipFuncAttributeMaxDynamicSharedMemorySize, LDS_BYTES) != hipSuccess) { fprintf(stderr, "kernel_launch: hipFuncSetAttribute failed\n"); grid = -1; return; }
        if (hipOccupancyMaxActiveBlocksPerMultiprocessor(&per_cu, (const void*)fwd, NTHREADS, LDS_BYTES) != hipSuccess || per_cu < 1) fprintf(stderr, "kernel_launch: occupancy query says %d\n", per_cu);
        (void)hipGetLastError();
        grid = cus;
    }
    if (grid < 0) return;
    (void)hipMemsetAsync((char*)d_ws + WS_CTL, 0, CTL_ZERO_BYTES, stream);
    Args a{};
    for (int i = 0; i < 20; ++i) a.in[i] = (const float*)d_in[i];
    a.out = (float*)d_out; a.ws = (unsigned char*)d_ws; a.pad = 0;
    if (N_LAUNCHES == 1) { a.ph_lo = 0; a.ph_hi = NPH; a.li = 0; hipLaunchKernelGGL(fwd, dim3(grid), dim3(NTHREADS), LDS_BYTES, stream, a); }
    else for (int p = 0; p < NPH; ++p) { a.ph_lo = p; a.ph_hi = p + 1; a.li = p; hipLaunchKernelGGL(fwd, dim3(grid), dim3(NTHREADS), LDS_BYTES, stream, a); }
}
```

```cpp
#include <hip/hip_runtime.h>
#include <cstdio>
#include <cstdint>

#ifndef N_LAUNCHES
#define N_LAUNCHES 1
#endif

#define LAS __attribute__((address_space(3)))
#define GAS __attribute__((address_space(1)))
typedef unsigned short bf16_t;
typedef short bf16x8 __attribute__((ext_vector_type(8)));
typedef float f32x4 __attribute__((ext_vector_type(4)));
typedef float f32x2 __attribute__((ext_vector_type(2)));
typedef unsigned u32x4 __attribute__((ext_vector_type(4)));
typedef unsigned u32x2 __attribute__((ext_vector_type(2)));
typedef int i32x8 __attribute__((ext_vector_type(8)));
typedef int i32x4 __attribute__((ext_vector_type(4)));

constexpr int T = 16384, SEQ = 4096, D = 2048, CC = 1024, NIN = 7168, NE = 32, DE = 2048;
constexpr float EPS = 1e-5f;
constexpr float YSCALE = 16.0f;
constexpr float XS = 8.0f;
constexpr float WSCALE = 32.0f;
constexpr int LCAP = 16384;
constexpr int MAXSLOT = 73728;

constexpr size_t MiB = 1u << 20;
constexpr size_t WS_CTL = 0, CTL_ZERO_BYTES = 1 * MiB;
constexpr size_t WS_RS1 = 1 * MiB;
constexpr size_t WS_SSQP = 2 * MiB;
constexpr size_t WS_WRT = 4 * MiB;
constexpr size_t WS_ONES = 4 * MiB + 512 * 1024;
constexpr size_t WS_SLOTREF = 5 * MiB;
constexpr size_t WS_LTOK = 6 * MiB;
constexpr size_t WS_LGATE = 8 * MiB;
constexpr size_t WS_LRS = 10 * MiB;
constexpr size_t WS_WPW = 12 * MiB;
constexpr size_t WS_WCO = 13 * MiB;
constexpr size_t WS_WPO = 17 * MiB;
constexpr size_t WS_WO = 21 * MiB;
constexpr size_t WS_WIN = 32 * MiB;
constexpr size_t WS_WIN8 = 48 * MiB;
constexpr size_t WS_XB8 = 544 * MiB;
constexpr size_t WS_XB = 64 * MiB;
constexpr size_t WS_U = 128 * MiB;
constexpr size_t WS_P = 160 * MiB;
constexpr size_t WS_G = 192 * MiB;
constexpr size_t WS_AC = 320 * MiB;
constexpr size_t WS_DP = 352 * MiB;
constexpr size_t WS_YP = 384 * MiB;
constexpr size_t WS_MG = 416 * MiB;
constexpr size_t WS_H = 480 * MiB;
constexpr size_t WS_HB = 608 * MiB;
constexpr size_t WS_W1 = 704 * MiB;
constexpr size_t WS_W2 = 1216 * MiB;
constexpr size_t WS_ACT = 1472 * MiB;
constexpr size_t WS_Y = 1760 * MiB;
constexpr size_t WS_END = 2048 * MiB;
constexpr int CW_BAR = 4096;
constexpr int CW_CNT = 16384;
constexpr int CW_QHEAD = 32768;

constexpr int STAGE_BYTES = 131072;
constexpr int L_MISC = STAGE_BYTES;
constexpr int L_CNT = L_MISC + 256;
constexpr int L_BASE = L_CNT + 128;
constexpr int L_NRT = L_BASE + 128;
constexpr int L_NU = L_NRT + 128;
constexpr int L_UNITS = L_NU + 16;
constexpr int L_TBL = STAGE_BYTES + 4096;
constexpr int LDS_BYTES = STAGE_BYTES + 8192;
constexpr int NTHREADS = 512, NWAVES = 8;

__device__ __forceinline__ unsigned f2bf(float f) { unsigned u = __builtin_bit_cast(unsigned, f); return (u + 0x7fffu + ((u >> 16) & 1u)) >> 16; }
__device__ __forceinline__ float bf2f(unsigned b) { return __builtin_bit_cast(float, b << 16); }
__device__ __forceinline__ unsigned cvt_pk_bf16(float lo, float hi) { unsigned r; asm volatile("v_cvt_pk_bf16_f32 %0, %1, %2" : "=v"(r) : "v"(lo), "v"(hi)); return r; }
__device__ __forceinline__ unsigned pk4_fp8(float a, float b, float c, float d) { int w = __builtin_amdgcn_cvt_pk_fp8_f32(a, b, 0, false); w = __builtin_amdgcn_cvt_pk_fp8_f32(c, d, w, true); return (unsigned)w; }
__device__ __forceinline__ float bflo(unsigned w) { return __builtin_bit_cast(float, w << 16); }
__device__ __forceinline__ float bfhi(unsigned w) { return __builtin_bit_cast(float, w & 0xffff0000u); }
__device__ __forceinline__ float sigmoidf_(float x) { return __builtin_amdgcn_rcpf(1.0f + __builtin_amdgcn_exp2f(-1.44269504f * x)); }
__device__ __forceinline__ float wave_sum(float v) {
#pragma unroll
    for (int o = 1; o < 64; o <<= 1) v += __shfl_xor(v, o);
    return v;
}
__device__ __forceinline__ int tid_opaque() { int t = threadIdx.x; asm volatile("" : "+v"(t)); return t; }
#define LDS_WAIT() asm volatile("s_waitcnt lgkmcnt(0)" ::: "memory")
#define VM_WAIT() asm volatile("s_waitcnt vmcnt(0)" ::: "memory")

#define XB_TMO      128
#define XB_XCNT(j)  (256  + 64 * (j))
#define XB_XSUB(j)  (1280 + 64 * (j))
#define XB_XGEN(j)  (2304 + 64 * (j))
#define XB_TOP      3328
#define XB_TOPGEN   3392
#define XCD_BAR_WORDS 3456
#define XB_SPIN_CAP (1u << 18)
__device__ __forceinline__ unsigned xb_ld(unsigned* p)              { return __hip_atomic_load(p, __ATOMIC_RELAXED, __HIP_MEMORY_SCOPE_AGENT); }
__device__ __forceinline__ unsigned xb_add(unsigned* p, unsigned v) { return __hip_atomic_fetch_add(p, v, __ATOMIC_RELAXED, __HIP_MEMORY_SCOPE_AGENT); }
__device__ __forceinline__ unsigned xb_xcc_id() { return (unsigned)__builtin_amdgcn_s_getreg((3 << 11) | 20) & 0xFu; }
#define XB_SPIN(cond, bar) do { unsigned _sp = 0; while (cond) { __builtin_amdgcn_s_sleep(1); \
    if ((++_sp & 255u) == 0u) { if (xb_ld(&(bar)[XB_TMO])) break; if (_sp > XB_SPIN_CAP) { atomicAdd(&(bar)[XB_TMO], 1u); break; } } } } while (0)
struct XcdBarrier { unsigned* bar; unsigned x; volatile LAS unsigned* st; };
__device__ __forceinline__ XcdBarrier xcd_barrier_post(unsigned* bar, volatile LAS unsigned* st) {
    XcdBarrier b; b.bar = bar; b.x = xb_xcc_id(); b.st = st;
    if (threadIdx.x == 0) (void)xb_add(&bar[XB_XCNT(b.x)], 1u);
    return b;
}
__device__ __forceinline__ void xcd_barrier_complete(unsigned* bar, unsigned x, unsigned& nloc, unsigned& nx) {
    const unsigned G = gridDim.x * gridDim.y * gridDim.z;
    unsigned sum, cnt, mine, sp = 0u;
    for (;;) {
        sum = 0u; cnt = 0u; mine = 0u;
#pragma unroll
        for (unsigned j = 0; j < 16; ++j) { const unsigned c = xb_ld(&bar[XB_XCNT(j)]); sum += c; cnt += (c > 0u) ? 1u : 0u; mine = (j == x) ? c : mine; }
        if (sum == G) break;
        __builtin_amdgcn_s_sleep(1);
        if ((++sp & 255u) == 0u) { if (xb_ld(&bar[XB_TMO])) break; if (sp > XB_SPIN_CAP) { atomicAdd(&bar[XB_TMO], 1u); break; } }
    }
    nloc = mine > 0u ? mine : 1u; nx = cnt > 0u ? cnt : 1u;
}
__device__ __forceinline__ void xcd_barrier(const XcdBarrier& b) {
    asm volatile("s_waitcnt vmcnt(0)" ::: "memory");
    __syncthreads();
    if (threadIdx.x == 0) {
        unsigned* bar = b.bar;
        __builtin_amdgcn_s_waitcnt(0);
        unsigned nloc = b.st[0], nx = b.st[1];
        if (nloc == 0u) { xcd_barrier_complete(bar, b.x, nloc, nx); b.st[0] = nloc; b.st[1] = nx; }
        const unsigned old = xb_add(&bar[XB_XSUB(b.x)], 1u);
        const unsigned gen = old / nloc;
        if (old + 1u == (gen + 1u) * nloc) {
            __builtin_amdgcn_fence(__ATOMIC_RELEASE, "agent");
            asm volatile("s_waitcnt vmcnt(0)" ::: "memory");
            const unsigned og = xb_add(&bar[XB_TOP], 1u);
            const unsigned tg = og / nx;
            if (og + 1u == (tg + 1u) * nx) xb_add(&bar[XB_TOPGEN], 1u);
            else XB_SPIN(xb_ld(&bar[XB_TOPGEN]) == tg, bar);
            __builtin_amdgcn_fence(__ATOMIC_ACQUIRE, "agent");
            xb_add(&bar[XB_XGEN(b.x)], 1u);
            asm volatile("s_waitcnt vmcnt(0)" ::: "memory");
        } else {
            XB_SPIN(xb_ld(&bar[XB_XGEN(b.x)]) == gen, bar);
            __builtin_amdgcn_fence(__ATOMIC_ACQUIRE, "agent");
            asm volatile("s_waitcnt vmcnt(0)" ::: "memory");
        }
    }
    __syncthreads();
}

constexpr int BM = 256, BK = 64, HALF = 128, HTB = HALF * BK * 2, NXCD = 8, WGM = 8;
__host__ __device__ __forceinline__ int lds_byte(int r, int c) { const int st = (r >> 4) * 2 + (c >> 5), rr = r & 15, cc = c & 31, ob = rr * 64 + cc * 2; return st * 1024 + (ob ^ (((ob >> 9) & 1) << 5)); }
__host__ __device__ __forceinline__ void stage_rc(int b, int& R, int& C) { const int st = b / 1024, sb = b % 1024, swz = sb ^ (((sb >> 9) & 1) << 5); R = (st >> 1) * 16 + swz / 64; C = (st & 1) * 32 + (swz % 64) / 2; }
__host__ __device__ __forceinline__ int perm32(int rho) { const int n = rho >> 4, i = rho & 15; return 8 * (i >> 2) + 4 * n + (i & 3); }

struct UnitD { const char* A; const char* B; int i0, i1, i2, i3; };

struct TileOrder {
    int nM, nN, nwg, wgm;
    __device__ __forceinline__ void init(int M, int N, int g = WGM) { nM = M / BM; nN = N / BM; nwg = nM * nN; wgm = g; }
    __device__ __forceinline__ bool get(int L, int& pm, int& pn) const {
        if (L >= nwg) return false;
        int wgid = L; { const int q = nwg / NXCD, r = nwg % NXCD, xcd = wgid % NXCD, off = wgid / NXCD; wgid = (xcd < r ? xcd * (q + 1) : r * (q + 1) + (xcd - r) * q) + off; }
        const int nig = wgm * nN, gid = wgid / nig, fm = gid * wgm, gsz = (nM - fm) < wgm ? (nM - fm) : wgm;
        pm = fm + ((wgid % nig) % gsz); pn = (wgid % nig) / gsz; return true;
    }
};

template <class Epi, class Sched, bool GATHER, bool FP8>
__device__ __forceinline__ void gemm_phase(LAS unsigned char* lds, const int KB, const int pitchB, const Sched& S, const Epi& E) {
    const int tid = tid_opaque(), wid = __builtin_amdgcn_readfirstlane(tid >> 6), lane = tid & 63, wr = wid >> 2, wc = wid & 3, fr = lane & 15, fq = lane >> 4;
    int Kk = KB; asm volatile("" : "+s"(Kk));
    const int nt = Kk / 128;
    int Rr[2], Cc[2]; unsigned voffB[2];
#pragma unroll
    for (int i = 0; i < 2; ++i) { stage_rc(tid * 16 + i * 8192, Rr[i], Cc[i]);
        const int R = Rr[i], rho = R & 31; const int Rb = Epi::CMAP ? 64 * (R >> 5) + 16 * ((rho >> 2) & 3) + 4 * (rho >> 4) + (rho & 3) : (R & ~31) + perm32(rho);
        voffB[i] = (unsigned)(Rb * pitchB + Cc[i] * 2); }
    const size_t kstep = (size_t)(BK * 2);
    const size_t hstep = (size_t)(Epi::CMAP ? 8 : HALF) * pitchB;
    const unsigned ldsw = (unsigned)wid * 1024u;
    const int aoff = lds_byte(wr * 64 + fr, fq * 8), boff = lds_byte(wc * 32 + fr, fq * 8);
#define PG8_SA(b, h) (((b) * 2 + (h)) * HTB)
#define PG8_SB(b, h) ((4 + (b) * 2 + (h)) * HTB)
#define PG8_STAGE(bufoff, gbase, voff) do { _Pragma("unroll") for (int _i = 0; _i < 2; ++_i) \
        __builtin_amdgcn_global_load_lds((const unsigned*)((const char*)(gbase) + (voff)[_i]), (LAS unsigned*)(lds + (bufoff) + ldsw + _i * 8192), 16, 0, 0); } while (0)
#define PG8_LDA(dst, b, h) do { _Pragma("unroll") for (int m = 0; m < 4; ++m) _Pragma("unroll") for (int k = 0; k < 2; ++k) dst[m][k] = *(const LAS bf16x8*)(lds + PG8_SA(b, h) + aoff + m * 2048 + k * 1024); } while (0)
#define PG8_LDB(dst, b, h) do { _Pragma("unroll") for (int n = 0; n < 2; ++n) _Pragma("unroll") for (int k = 0; k < 2; ++k) dst[n][k] = *(const LAS bf16x8*)(lds + PG8_SB(b, h) + boff + n * 2048 + k * 1024); } while (0)
#define PG8_MMA(ai, bj, At, Bt) do { __builtin_amdgcn_s_setprio(1); _Pragma("unroll") for (int m = 0; m < 4; ++m) _Pragma("unroll") for (int n = 0; n < 2; ++n) { \
        if constexpr (FP8) { const i32x4 a0_ = __builtin_bit_cast(i32x4, At[m][0]), a1_ = __builtin_bit_cast(i32x4, At[m][1]), b0_ = __builtin_bit_cast(i32x4, Bt[n][0]), b1_ = __builtin_bit_cast(i32x4, Bt[n][1]); \
            const i32x8 a_ = __builtin_shufflevector(a0_, a1_, 0, 1, 2, 3, 4, 5, 6, 7), b_ = __builtin_shufflevector(b0_, b1_, 0, 1, 2, 3, 4, 5, 6, 7); \
            asm volatile("s_nop 1\n\tv_mfma_f32_16x16x128_f8f6f4 %0, %1, %2, %0" : "+v"(acc[ai][bj][m][n]) : "v"(b_), "v"(a_)); } \
        else { _Pragma("unroll") for (int k = 0; k < 2; ++k) acc[ai][bj][m][n] = __builtin_amdgcn_mfma_f32_16x16x32_bf16(Bt[n][k], At[m][k], acc[ai][bj][m][n], 0, 0, 0); } } \
        __builtin_amdgcn_s_setprio(0); } while (0)
#define PG8_WAIT_V(n) asm volatile("s_waitcnt vmcnt(" #n ")" ::: "memory")
#define PG8_WAIT_L(n) asm volatile("s_waitcnt lgkmcnt(" #n ")" ::: "memory")
#define PG8_BAR __builtin_amdgcn_s_barrier()
#define PG8_SCHED __builtin_amdgcn_sched_barrier(0)
    UnitD cur, nxt; int ui = 0;
    if (!S.next(0, cur)) return;
    unsigned vA[2][2], vN[2][2];
#pragma unroll
    for (int h = 0; h < 2; ++h)
#pragma unroll
        for (int i = 0; i < 2; ++i) { vA[h][i] = S.a_off(cur, h, Rr[i], Cc[i]); vN[h][i] = vA[h][i]; }
    f32x4 acc[2][2][4][2];
#pragma unroll
    for (int a = 0; a < 2; ++a)
#pragma unroll
        for (int b = 0; b < 2; ++b)
#pragma unroll
            for (int m = 0; m < 4; ++m)
#pragma unroll
                for (int n = 0; n < 2; ++n) acc[a][b][m][n] = (f32x4){0.f, 0.f, 0.f, 0.f};
    bf16x8 At[4][2], B0[2][2], B1[2][2];
    const char* cA = cur.A; const char* cB = cur.B;
    PG8_STAGE(PG8_SB(0, 0), cB, voffB); PG8_STAGE(PG8_SB(0, 1), cB + hstep, voffB); PG8_STAGE(PG8_SA(0, 0), cA, vA[0]); PG8_STAGE(PG8_SA(0, 1), cA, vA[1]);
    if (wr == 1) PG8_BAR;
    PG8_WAIT_V(2); PG8_BAR;
    PG8_STAGE(PG8_SB(1, 0), cB + kstep, voffB); PG8_STAGE(PG8_SA(1, 0), cA + kstep, vA[0]); PG8_STAGE(PG8_SB(1, 1), cB + hstep + kstep, voffB);
    PG8_WAIT_V(6); PG8_BAR;
    for (;;) {
        const bool has_next = S.next(ui + 1, nxt);
        bool do0 = true, do1 = true;
        if constexpr (Epi::RSKIP) { const int vr = cur.i3 - cur.i1 * 256; do0 = (64 * wr) < vr; do1 = (128 + 64 * wr) < vr; }
        float tv = E.tbl_fetch(cur, wid, lane);
        int rawN[2][2];
        if constexpr (GATHER) {
#pragma unroll
            for (int h = 0; h < 2; ++h)
#pragma unroll
                for (int i = 0; i < 2; ++i) rawN[h][i] = S.tok_fetch(has_next ? nxt : cur, h, Rr[i]);
        }
        const char* nA = has_next ? nxt.A : cA; const char* nB = has_next ? nxt.B : cB;
        for (int t = 0; t < nt; t += 2) {
            const bool last = (t == nt - 2);
            const char* a1 = cA + (size_t)(t + 1) * kstep;
            const char* a2 = last ? nA : cA + (size_t)(t + 2) * kstep; const char* b2 = last ? nB : cB + (size_t)(t + 2) * kstep;
            const char* a3 = a2 + kstep; const char* b3 = b2 + kstep;
            unsigned x0[2], x1[2];
            if constexpr (GATHER) {
                asm volatile("" : "+v"(rawN[0][0]), "+v"(rawN[0][1]), "+v"(rawN[1][0]), "+v"(rawN[1][1]));
#pragma unroll
                for (int h = 0; h < 2; ++h)
#pragma unroll
                    for (int i = 0; i < 2; ++i) vN[h][i] = S.tok_off(has_next ? nxt : cur, h, Rr[i], Cc[i], rawN[h][i]);
                x0[0] = last ? vN[0][0] : vA[0][0]; x0[1] = last ? vN[0][1] : vA[0][1]; x1[0] = last ? vN[1][0] : vA[1][0]; x1[1] = last ? vN[1][1] : vA[1][1]; }
            else { x0[0] = vA[0][0]; x0[1] = vA[0][1]; x1[0] = vA[1][0]; x1[1] = vA[1][1]; }
            PG8_LDB(B0, 0, 0); PG8_LDB(B1, 0, 1); PG8_SCHED; if (do0) { PG8_LDA(At, 0, 0); } PG8_STAGE(PG8_SA(1, 1), a1, vA[1]);
            PG8_WAIT_V(8); PG8_WAIT_L(0); PG8_BAR; if (do0) { PG8_MMA(0, 0, At, B0); PG8_MMA(0, 1, At, B1); } PG8_BAR; PG8_SCHED;
            if (do1) { PG8_LDA(At, 0, 1); } PG8_STAGE(PG8_SB(0, 0), b2, voffB); PG8_STAGE(PG8_SB(0, 1), b2 + hstep, voffB); PG8_STAGE(PG8_SA(0, 0), a2, x0);
            PG8_WAIT_V(8); PG8_WAIT_L(0); PG8_BAR; if (do1) { PG8_MMA(1, 0, At, B0); PG8_MMA(1, 1, At, B1); } PG8_BAR; PG8_SCHED;
            PG8_LDB(B0, 1, 0); PG8_LDB(B1, 1, 1); PG8_SCHED; if (do0) { PG8_LDA(At, 1, 0); } PG8_STAGE(PG8_SA(0, 1), a2, x1);
            PG8_WAIT_V(8); PG8_WAIT_L(0); PG8_BAR; if (do0) { PG8_MMA(0, 0, At, B0); PG8_MMA(0, 1, At, B1); } PG8_BAR; PG8_SCHED;
            if (do1) { PG8_LDA(At, 1, 1); } PG8_STAGE(PG8_SB(1, 0), b3, voffB); PG8_STAGE(PG8_SB(1, 1), b3 + hstep, voffB); PG8_STAGE(PG8_SA(1, 0), a3, x0);
            PG8_WAIT_V(8); PG8_WAIT_L(0); PG8_BAR; if (do1) { PG8_MMA(1, 0, At, B0); PG8_MMA(1, 1, At, B1); } PG8_BAR; PG8_SCHED;
        }
        if (wr == 0) PG8_BAR;
        if constexpr (Epi::TBL) { E.tbl_put(tv, lds, wid, lane, ui & 1); PG8_WAIT_L(0); PG8_BAR; }
        if constexpr (FP8) asm volatile("s_nop 15\n\ts_nop 15" ::: "memory");
        E(acc, cur, wr, wc, fr, fq, ui & 1);
        if (!has_next) break;
        if (!E.keep(cur)) {
#pragma unroll
            for (int a = 0; a < 2; ++a)
#pragma unroll
                for (int b = 0; b < 2; ++b)
#pragma unroll
                    for (int m = 0; m < 4; ++m)
#pragma unroll
                        for (int n = 0; n < 2; ++n) acc[a][b][m][n] = (f32x4){0.f, 0.f, 0.f, 0.f};
        }
        cur = nxt; cA = nA; cB = nB; ++ui;
#pragma unroll
        for (int h = 0; h < 2; ++h)
#pragma unroll
            for (int i = 0; i < 2; ++i) vA[h][i] = vN[h][i];
        if (wr == 1) PG8_BAR;
    }
    PG8_WAIT_V(0);
    PG8_BAR;
#undef PG8_SA
#undef PG8_SB
#undef PG8_STAGE
#undef PG8_LDA
#undef PG8_LDB
#undef PG8_MMA
#undef PG8_WAIT_V
#undef PG8_WAIT_L
#undef PG8_BAR
#undef PG8_SCHED
}

struct Args { const float* in[20]; float* out; unsigned char* ws; int ph_lo, ph_hi, li, pad; };

#define CAS __attribute__((address_space(4)))
__device__ __forceinline__ const float* in_ptr(int i) { const CAS Args* ka = (const CAS Args*)__builtin_amdgcn_kernarg_segment_ptr(); asm volatile("" : "+s"(ka)); return ka->in[i]; }
__device__ __forceinline__ float* out_ptr() { const CAS Args* ka = (const CAS Args*)__builtin_amdgcn_kernarg_segment_ptr(); asm volatile("" : "+s"(ka)); return ka->out; }
struct Frame {
    LAS unsigned char* lds;
    unsigned char* ws;
    int G, bx;
};
#define PHASE_IDS() const int tid = tid_opaque(), lane = tid & 63, wave = __builtin_amdgcn_readfirstlane(tid >> 6); (void)lane; (void)wave

struct DenseSched {
    const char* A; const char* B; int lda, ldb, G, c; TileOrder to;
    __device__ __forceinline__ bool next(int i, UnitD& u) const {
        int pm, pn; if (!to.get(i * G + c, pm, pn)) return false;
        u.A = A + (size_t)pm * 256 * lda * 2; u.B = B + (size_t)pn * 256 * ldb * 2; u.i0 = pm; u.i1 = pn; u.i2 = 0; u.i3 = 0; return true;
    }
    __device__ __forceinline__ unsigned a_off(const UnitD&, int h, int R, int C) const { return (unsigned)((h * 128 + R) * lda + C) * 2u; }
};
struct DenseSched8 {
    const char* A; const char* B; int lda, ldb, G, c; TileOrder to;
    __device__ __forceinline__ bool next(int i, UnitD& u) const {
        int pm, pn; if (!to.get(i * G + c, pm, pn)) return false;
        u.A = A + (size_t)pm * 256 * lda; u.B = B + (size_t)pn * 256 * ldb; u.i0 = pm; u.i1 = pn; u.i2 = 0; u.i3 = 0; return true;
    }
    __device__ __forceinline__ unsigned a_off(const UnitD&, int h, int R, int C) const { return (unsigned)((h * 128 + R) * lda + C * 2); }
};
struct PoolSched {
    const char* A; const char* B; int G, c;
    __device__ __forceinline__ bool next(int i, UnitD& u) const {
        const int L = i * G + c; if (L >= 32) return false;
        const int pm = L >> 2, g = L & 3;
        u.A = A + ((size_t)pm * 256 * CC + g * 256) * 2; u.B = B + (size_t)g * 65536 * 2; u.i0 = pm; u.i1 = g; u.i2 = 0; u.i3 = 0; return true;
    }
    __device__ __forceinline__ unsigned a_off(const UnitD&, int h, int R, int C) const { return (unsigned)((h * 128 + R) * CC + C) * 2u; }
};
struct MergeSched {
    const char* A0; const char* A1; const char* B0; const char* B1; int G, c; TileOrder to;
    __device__ __forceinline__ bool next(int i, UnitD& u) const {
        int pm, pn; if (!to.get((i >> 1) * G + c, pm, pn)) return false;
        const int part = i & 1;
        u.A = (part ? A1 : A0) + (size_t)pm * 256 * CC * 2; u.B = (part ? B1 : B0) + (size_t)pn * 256 * CC * 2; u.i0 = pm; u.i1 = pn; u.i2 = part; u.i3 = 0; return true;
    }
    __device__ __forceinline__ unsigned a_off(const UnitD&, int h, int R, int C) const { return (unsigned)((h * 128 + R) * CC + C) * 2u; }
};
struct MoeSched {
    LAS unsigned char* lds; const char* A; const char* B; const int* ltok; int gather; int nrows_w;
    __device__ __forceinline__ bool next(int i, UnitD& u) const {
        const int nu = __builtin_amdgcn_readfirstlane(((const LAS int*)(lds + L_NU))[0]); if (i >= nu) return false;
        const int code = __builtin_amdgcn_readfirstlane(((const LAS int*)(lds + L_UNITS))[i]); const int e = code >> 16, rt = (code >> 8) & 0xff, ct = code & 0xff;
        const int cnt = __builtin_amdgcn_readfirstlane(((const LAS int*)(lds + L_CNT))[e]), base = __builtin_amdgcn_readfirstlane(((const LAS int*)(lds + L_BASE))[e]);
        u.A = gather ? A : A + (size_t)(base + rt * 256) * DE;
        u.B = B + ((size_t)e * nrows_w + (size_t)ct * 256) * DE;
        u.i0 = e; u.i1 = rt; u.i2 = ct; u.i3 = cnt; return true;
    }
    __device__ __forceinline__ int tok_fetch(const UnitD& u, int h, int R) const {
        int v; const int* p = ltok + u.i0 * LCAP + u.i1 * 256 + h * 128 + R; asm volatile("global_load_dword %0, %1, off" : "=v"(v) : "v"(p) : "memory"); return v; }
    __device__ __forceinline__ unsigned tok_off(const UnitD& u, int h, int R, int C, int raw) const {
        const int sr = u.i1 * 256 + h * 128 + R; const int tok = (sr < u.i3) ? raw : 0; return (unsigned)(tok * DE + C * 2); }
    __device__ __forceinline__ unsigned a_off(const UnitD& u, int h, int R, int C) const {
        if (gather) { const int sr = u.i1 * 256 + h * 128 + R; const int tok = (sr < u.i3) ? ltok[u.i0 * LCAP + sr] : 0; return (unsigned)(tok * DE + C * 2); }
        return (unsigned)((h * 128 + R) * DE + C * 2);
    }
};

#define EPI_FENCE() asm volatile("" ::: "memory")
__device__ __forceinline__ u32x4 pack8(const f32x4 a, const f32x4 b) { u32x4 w; w.x = cvt_pk_bf16(a[0], a[1]); w.y = cvt_pk_bf16(a[2], a[3]); w.z = cvt_pk_bf16(b[0], b[1]); w.w = cvt_pk_bf16(b[2], b[3]); return w; }
__device__ __forceinline__ f32x4 sig4(const f32x4 v) { return (f32x4){sigmoidf_(v[0]), sigmoidf_(v[1]), sigmoidf_(v[2]), sigmoidf_(v[3])}; }
__device__ __forceinline__ void unpack8(const u32x4 w, f32x4& a, f32x4& b) { a = (f32x4){bflo(w.x), bfhi(w.x), bflo(w.y), bfhi(w.y)}; b = (f32x4){bflo(w.z), bfhi(w.z), bflo(w.w), bfhi(w.w)}; }

__device__ __forceinline__ unsigned pack4u(const f32x4 v) { const unsigned a = (unsigned)(v[0] * 255.0f + 0.5f), b = (unsigned)(v[1] * 255.0f + 0.5f), c = (unsigned)(v[2] * 255.0f + 0.5f), d = (unsigned)(v[3] * 255.0f + 0.5f); return a | (b << 8) | (c << 16) | (d << 24); }
__device__ __forceinline__ f32x4 unpack4u(unsigned w) { return (f32x4){(float)(w & 0xffu), (float)((w >> 8) & 0xffu), (float)((w >> 16) & 0xffu), (float)(w >> 24)} * (1.0f / 255.0f); }
__device__ __forceinline__ float tbl_load(const float* g, int lane) { float v; const float* p = g + lane; asm volatile("global_load_dword %0, %1, off" : "=v"(v) : "v"(p) : "memory"); return v; }
__device__ __forceinline__ void tbl_store(float v, LAS unsigned char* lds, int par, int slot, int lane) { asm volatile("" : "+v"(v)); ((LAS float*)(lds + L_TBL + par * 2048 + slot * 256))[lane] = v; }
struct EpiWin {
    bf16_t* U; bf16_t* P; const float* rs1;
    LAS unsigned char* lds;
    __device__ __forceinline__ float tbl_fetch(const UnitD& u, int wid, int lane) const { return tbl_load(rs1 + u.i0 * 256 + (wid & 3) * 64, lane); }
    __device__ __forceinline__ void tbl_put(float v, LAS unsigned char* l, int wid, int lane, int par) const { if (wid < 4) tbl_store(v, l, par, wid, lane); }
    static constexpr int CMAP = 0;
    static constexpr bool RSKIP = false;
    static constexpr bool TBL = true;
    __device__ __forceinline__ bool keep(const UnitD&) const { return false; }
    __device__ __forceinline__ void operator()(f32x4 (&acc)[2][2][4][2], const UnitD& u, int wr, int wc, int fr, int fq, int par) const {
        const int pm = u.i0, pn = u.i1; const int row0 = pm * 256 + wr * 64 + fr, cl = wc * 32 + 8 * fq;
        const LAS float* trs = (const LAS float*)(lds + L_TBL + par * 2048) + wr * 64 + fr;
        if (pn < 8) {
#pragma unroll
            for (int ai = 0; ai < 2; ++ai)
#pragma unroll
                for (int m = 0; m < 4; ++m) { const int r = row0 + ai * 128 + m * 16; const float rs = trs[ai * 128 + m * 16];
                    const f32x4 a0 = acc[ai][0][m][0] * rs, a1 = acc[ai][0][m][1] * rs, g0 = acc[ai][1][m][0] * rs, g1 = acc[ai][1][m][1] * rs;
                    *(u32x4*)(U + (size_t)r * CC + pn * 128 + cl) = pack8(a0 * sig4(g0), a1 * sig4(g1)); }
        } else {
#pragma unroll
            for (int ai = 0; ai < 2; ++ai)
#pragma unroll
                for (int m = 0; m < 4; ++m) { const int r = row0 + ai * 128 + m * 16; const float rs = trs[ai * 128 + m * 16];
#pragma unroll
                    for (int bj = 0; bj < 2; ++bj) *(u32x4*)(P + (size_t)r * CC + (pn - 8) * 256 + bj * 128 + cl) = pack8(acc[ai][bj][m][0] * rs, acc[ai][bj][m][1] * rs); }
        }
    }
};
struct EpiGate {
    unsigned char* Gq; const float* rs1;
    LAS unsigned char* lds;
    __device__ __forceinline__ float tbl_fetch(const UnitD& u, int wid, int lane) const { return tbl_load(rs1 + u.i0 * 256 + (wid & 3) * 64, lane); }
    __device__ __forceinline__ void tbl_put(float v, LAS unsigned char* l, int wid, int lane, int par) const { if (wid < 4) tbl_store(v, l, par, wid, lane); }
    static constexpr int CMAP = 0;
    static constexpr bool RSKIP = false;
    static constexpr bool TBL = true;
    __device__ __forceinline__ bool keep(const UnitD&) const { return false; }
    __device__ __forceinline__ void operator()(f32x4 (&acc)[2][2][4][2], const UnitD& u, int wr, int wc, int fr, int fq, int par) const {
        const int pm = u.i0, pn = u.i1; const int row0 = pm * 256 + wr * 64 + fr, cl = wc * 32 + 8 * fq;
        const LAS float* trs = (const LAS float*)(lds + L_TBL + par * 2048) + wr * 64 + fr;
#pragma unroll
        for (int ai = 0; ai < 2; ++ai)
#pragma unroll
            for (int m = 0; m < 4; ++m) { const int r = row0 + ai * 128 + m * 16; const float rs = trs[ai * 128 + m * 16] * (1.0f / (WSCALE * XS));
                { const f32x4 c0 = sig4(acc[ai][0][m][0] * rs), c1 = sig4(acc[ai][0][m][1] * rs), p0 = sig4(acc[ai][1][m][0] * rs), p1 = sig4(acc[ai][1][m][1] * rs);
                  u32x2 qc, qp; qc.x = pack4u(c0); qc.y = pack4u(c1); qp.x = pack4u(p0); qp.y = pack4u(p1);
                  __builtin_nontemporal_store(qc, (u32x2*)(Gq + (size_t)r * 4096 + pn * 128 + cl));
                  __builtin_nontemporal_store(qp, (u32x2*)(Gq + (size_t)r * 4096 + 2048 + pn * 128 + cl)); } }
    }
};
struct EpiPool {
    bf16_t* YP;
    __device__ __forceinline__ float tbl_fetch(const UnitD&, int, int) const { return 0.f; }
    __device__ __forceinline__ void tbl_put(float, LAS unsigned char*, int, int, int) const {}
    static constexpr int CMAP = 0;
    static constexpr bool RSKIP = false;
    static constexpr bool TBL = false;
    __device__ __forceinline__ bool keep(const UnitD&) const { return false; }
    __device__ __forceinline__ void operator()(f32x4 (&acc)[2][2][4][2], const UnitD& u, int wr, int wc, int fr, int fq, int par) const {
        const int pm = u.i0, g = u.i1; const int row0 = pm * 256 + wr * 64 + fr, cl = g * 256 + wc * 32 + 8 * fq;
#pragma unroll
        for (int ai = 0; ai < 2; ++ai)
#pragma unroll
            for (int m = 0; m < 4; ++m) { const int r = row0 + ai * 128 + m * 16;
#pragma unroll
                for (int bj = 0; bj < 2; ++bj) *(u32x4*)(YP + (size_t)r * CC + cl + bj * 128) = pack8(acc[ai][bj][m][0], acc[ai][bj][m][1]); }
    }
};
struct EpiMerge {
    bf16_t* MG; const unsigned char* Gq;
    __device__ __forceinline__ float tbl_fetch(const UnitD&, int, int) const { return 0.f; }
    __device__ __forceinline__ void tbl_put(float, LAS unsigned char*, int, int, int) const {}
    static constexpr int CMAP = 0;
    static constexpr bool RSKIP = false;
    static constexpr bool TBL = false;
    __device__ __forceinline__ bool keep(const UnitD& u) const { return u.i2 == 0; }
    __device__ __forceinline__ void operator()(f32x4 (&acc)[2][2][4][2], const UnitD& u, int wr, int wc, int fr, int fq, int par) const {
        const int pm = u.i0, pn = u.i1, part = u.i2; const int row0 = pm * 256 + wr * 64 + fr, cl = pn * 256 + wc * 32 + 8 * fq;
        if (part == 0) {
#pragma unroll
            for (int ai = 0; ai < 2; ++ai)
#pragma unroll
                for (int m = 0; m < 4; ++m) { const int r = row0 + ai * 128 + m * 16;
#pragma unroll
                    for (int bj = 0; bj < 2; ++bj) { const u32x2 wc_ = *(const u32x2*)(Gq + (size_t)r * 4096 + cl + bj * 128), wp_ = *(const u32x2*)(Gq + (size_t)r * 4096 + 2048 + cl + bj * 128);
                        f32x4 q0 = unpack4u(wc_.x), q1 = unpack4u(wc_.y); const f32x4 p0 = unpack4u(wp_.x), p1 = unpack4u(wp_.y);
#pragma unroll
                        for (int j = 0; j < 4; ++j) { q0[j] = q0[j] * __builtin_amdgcn_rcpf(fmaxf(p0[j], 1e-6f)); q1[j] = q1[j] * __builtin_amdgcn_rcpf(fmaxf(p1[j], 1e-6f)); }
                        acc[ai][bj][m][0] = acc[ai][bj][m][0] * q0; acc[ai][bj][m][1] = acc[ai][bj][m][1] * q1; }
                    EPI_FENCE(); }
        } else {
#pragma unroll
            for (int ai = 0; ai < 2; ++ai)
#pragma unroll
                for (int m = 0; m < 4; ++m) { const int r = row0 + ai * 128 + m * 16;
#pragma unroll
                    for (int bj = 0; bj < 2; ++bj) { const u32x2 wp_ = *(const u32x2*)(Gq + (size_t)r * 4096 + 2048 + cl + bj * 128);
                        f32x4 p0 = unpack4u(wp_.x), p1 = unpack4u(wp_.y);
#pragma unroll
                        for (int j = 0; j < 4; ++j) { p0[j] = fmaxf(p0[j], 1e-6f); p1[j] = fmaxf(p1[j], 1e-6f); }
                        *(u32x4*)(MG + (size_t)r * D + cl + bj * 128) = pack8(acc[ai][bj][m][0] * p0, acc[ai][bj][m][1] * p1); }
                    EPI_FENCE(); }
        }
    }
};
struct EpiWo {
    const bf16_t* x; bf16_t* H; unsigned char* HQ; float* SSQP; const float* g2;
    __device__ __forceinline__ float tbl_fetch(const UnitD&, int, int) const { return 0.f; }
    __device__ __forceinline__ void tbl_put(float, LAS unsigned char*, int, int, int) const {}
    static constexpr int CMAP = 1;
    static constexpr bool RSKIP = false;
    static constexpr bool TBL = false;
    __device__ __forceinline__ bool keep(const UnitD&) const { return false; }
    __device__ __forceinline__ void operator()(f32x4 (&acc)[2][2][4][2], const UnitD& u, int wr, int wc, int fr, int fq, int par) const {
        const int pm = u.i0, pn = u.i1; const int row0 = pm * 256 + wr * 64 + fr, cl = pn * 256 + wc * 64 + 16 * fq;
        f32x4 gg[4];
#pragma unroll
        for (int c = 0; c < 4; ++c) gg[c] = *(const f32x4*)(g2 + cl + 4 * c);
#pragma unroll
        for (int ai = 0; ai < 2; ++ai)
#pragma unroll
            for (int m = 0; m < 4; ++m) { const int r = row0 + ai * 128 + m * 16; const size_t o = (size_t)r * D + cl; float ss = 0.f;
                f32x4 h[4], xv[4]; { const u32x4 xa = *(const u32x4*)(x + o), xb2 = *(const u32x4*)(x + o + 8); unpack8(xa, xv[0], xv[1]); unpack8(xb2, xv[2], xv[3]); }
#pragma unroll
                for (int c = 0; c < 4; ++c) { h[c] = xv[c] + acc[ai][c >> 1][m][c & 1]; ss += (h[c][0] * h[c][0] + h[c][1] * h[c][1]) + (h[c][2] * h[c][2] + h[c][3] * h[c][3]); }
                *(u32x4*)(H + o) = pack8(h[0], h[1]); *(u32x4*)(H + o + 8) = pack8(h[2], h[3]);
                u32x4 q;
#pragma unroll
                for (int c = 0; c < 4; ++c) { const f32x4 t = h[c] * gg[c]; q[c] = pk4_fp8(t[0], t[1], t[2], t[3]); }
                *(u32x4*)(HQ + o) = q;
                ss += __shfl_xor(ss, 16); ss += __shfl_xor(ss, 32);
                if (fq == 0) SSQP[(size_t)r * 32 + pn * 4 + wc] = ss;
                EPI_FENCE(); }
    }
};
struct EpiMoe1 {
    unsigned char* ACT; const float* b1; const float* lrs; LAS unsigned char* lds;
    __device__ __forceinline__ float tbl_fetch(const UnitD& u, int wid, int lane) const {
        const float* g = (wid < 4) ? lrs + (size_t)u.i0 * LCAP + u.i1 * 256 + wid * 64 : b1 + (size_t)u.i0 * 4096 + u.i2 * 128 + ((wid >= 6) ? 2048 + (wid - 6) * 64 : (wid - 4) * 64);
        return tbl_load(g, lane); }
    __device__ __forceinline__ void tbl_put(float v, LAS unsigned char* l, int wid, int lane, int par) const { tbl_store(wid >= 6 ? v + 1.0f : v, l, par, wid, lane); }
    static constexpr int CMAP = 0;
    static constexpr bool RSKIP = true;
    static constexpr bool TBL = true;
    __device__ __forceinline__ bool keep(const UnitD&) const { return false; }
    __device__ __forceinline__ void operator()(f32x4 (&acc)[2][2][4][2], const UnitD& u, int wr, int wc, int fr, int fq, int par) const {
        const int e = u.i0, rt = u.i1, ct = u.i2, cnt = u.i3; const int base = __builtin_amdgcn_readfirstlane(((const LAS int*)(lds + L_BASE))[e]);
        const int sr0 = rt * 256 + wr * 64 + fr, cl = ct * 128 + wc * 32 + 8 * fq;
        const LAS float* tb = (const LAS float*)(lds + L_TBL + par * 2048);
        f32x4 bg[2], bl[2];
#pragma unroll
        for (int n = 0; n < 2; ++n) { bg[n] = *(const LAS f32x4*)(tb + 256 + wc * 32 + 8 * fq + 4 * n); bl[n] = *(const LAS f32x4*)(tb + 384 + wc * 32 + 8 * fq + 4 * n); }
#pragma unroll
        for (int ai = 0; ai < 2; ++ai) { if (ai * 128 + wr * 64 >= cnt - rt * 256) continue;
#pragma unroll
            for (int m = 0; m < 4; ++m) { const int sr = sr0 + ai * 128 + m * 16; const float rs = tb[ai * 128 + wr * 64 + m * 16 + fr] * (1.0f / WSCALE);
                f32x4 o[2];
                const f32x2 rs2 = (f32x2){rs, rs};
#pragma unroll
                for (int n = 0; n < 2; ++n)
#pragma unroll
                    for (int jp = 0; jp < 2; ++jp) {
                        const f32x2 ag = (f32x2){acc[ai][0][m][n][2 * jp], acc[ai][0][m][n][2 * jp + 1]}, al_ = (f32x2){acc[ai][1][m][n][2 * jp], acc[ai][1][m][n][2 * jp + 1]};
                        const f32x2 bg2 = (f32x2){bg[n][2 * jp], bg[n][2 * jp + 1]}, bl2 = (f32x2){bl[n][2 * jp], bl[n][2 * jp + 1]};
                        const f32x2 hg = __builtin_elementwise_fma(ag, rs2, bg2), hl = __builtin_elementwise_fma(al_, rs2, bl2);
                        f32x2 xg, xl; xg[0] = fminf(hg[0], 7.0f); xg[1] = fminf(hg[1], 7.0f); xl[0] = fminf(fmaxf(hl[0], -6.0f), 8.0f); xl[1] = fminf(fmaxf(hl[1], -6.0f), 8.0f);
                        const f32x2 t = xg * (-1.702f * 1.44269504f);
                        f32x2 ex; ex[0] = __builtin_amdgcn_exp2f(t[0]); ex[1] = __builtin_amdgcn_exp2f(t[1]);
                        const f32x2 dn = ex + 1.0f;
                        f32x2 rc; rc[0] = __builtin_amdgcn_rcpf(dn[0]); rc[1] = __builtin_amdgcn_rcpf(dn[1]);
                        const f32x2 ov = (xg * rc) * xl;
                        o[n][2 * jp] = ov[0]; o[n][2 * jp + 1] = ov[1]; }
                { u32x2 q; q.x = pk4_fp8(o[0][0], o[0][1], o[0][2], o[0][3]); q.y = pk4_fp8(o[1][0], o[1][1], o[1][2], o[1][3]); *(u32x2*)(ACT + (size_t)(base + sr) * DE + cl) = q; } } }
    }
};
struct EpiMoe2 {
    unsigned char* Y; const float* b2; const float* lgate; LAS unsigned char* lds;
    __device__ __forceinline__ float tbl_fetch(const UnitD& u, int wid, int lane) const {
        const float* g = (wid < 4) ? lgate + (size_t)u.i0 * LCAP + u.i1 * 256 + wid * 64 : b2 + (size_t)u.i0 * D + u.i2 * 256 + (wid - 4) * 64;
        return tbl_load(g, lane); }
    __device__ __forceinline__ void tbl_put(float v, LAS unsigned char* l, int wid, int lane, int par) const { tbl_store(v, l, par, wid, lane); }
    static constexpr int CMAP = 1;
    static constexpr bool RSKIP = true;
    static constexpr bool TBL = true;
    __device__ __forceinline__ bool keep(const UnitD&) const { return false; }
    __device__ __forceinline__ void operator()(f32x4 (&acc)[2][2][4][2], const UnitD& u, int wr, int wc, int fr, int fq, int par) const {
        const int e = u.i0, rt = u.i1, ct = u.i2; const int base = __builtin_amdgcn_readfirstlane(((const LAS int*)(lds + L_BASE))[e]);
        const int sr0 = rt * 256 + wr * 64 + fr, cl = ct * 256 + wc * 64 + 16 * fq;
        const LAS float* tb = (const LAS float*)(lds + L_TBL + par * 2048);
        f32x4 bb[2][2];
#pragma unroll
        for (int bj = 0; bj < 2; ++bj)
#pragma unroll
            for (int n = 0; n < 2; ++n) bb[bj][n] = *(const LAS f32x4*)(tb + 256 + wc * 64 + 16 * fq + 8 * bj + 4 * n);
#pragma unroll
        for (int ai = 0; ai < 2; ++ai) { if (ai * 128 + wr * 64 >= u.i3 - rt * 256) continue;
#pragma unroll
            for (int m = 0; m < 4; ++m) { const int sr = sr0 + ai * 128 + m * 16; const float gt = tb[ai * 128 + wr * 64 + m * 16 + fr] * YSCALE;
                u32x4 q;
                { const f32x4 v = (acc[ai][0][m][0] * (1.0f / WSCALE) + bb[0][0]) * gt; q.x = pk4_fp8(v[0], v[1], v[2], v[3]); }
                { const f32x4 v = (acc[ai][0][m][1] * (1.0f / WSCALE) + bb[0][1]) * gt; q.y = pk4_fp8(v[0], v[1], v[2], v[3]); }
                { const f32x4 v = (acc[ai][1][m][0] * (1.0f / WSCALE) + bb[1][0]) * gt; q.z = pk4_fp8(v[0], v[1], v[2], v[3]); }
                { const f32x4 v = (acc[ai][1][m][1] * (1.0f / WSCALE) + bb[1][1]) * gt; q.w = pk4_fp8(v[0], v[1], v[2], v[3]); }
                *(u32x4*)(Y + (size_t)(base + sr) * D + cl) = q; } }
    }
};

__device__ __forceinline__ void tr_item(const float* W, int N, const float* ks, bf16_t* WT, int ldk, int k0, int n0, int drow0, LAS unsigned* tile, int lane) {
    const int kq = lane >> 4, nq = lane & 15;
    f32x4 v[8][2];
#pragma unroll
    for (int i2 = 0; i2 < 8; ++i2)
#pragma unroll
        for (int s = 0; s < 2; ++s) v[i2][s] = __builtin_nontemporal_load((const f32x4*)(W + (size_t)(k0 + 8 * i2 + 2 * kq + s) * N + n0 + 4 * nq));
    if (ks) {
#pragma unroll
        for (int i2 = 0; i2 < 8; ++i2)
#pragma unroll
            for (int s = 0; s < 2; ++s) v[i2][s] = v[i2][s] * ks[k0 + 8 * i2 + 2 * kq + s];
    }
#pragma unroll
    for (int i2 = 0; i2 < 8; ++i2)
#pragma unroll
        for (int j = 0; j < 4; ++j) tile[(4 * nq + j) * 32 + ((i2 ^ (nq & 7)) * 4) + kq] = cvt_pk_bf16(v[i2][0][j], v[i2][1][j]);
    LDS_WAIT();
    const int nr = lane >> 3, kc = lane & 7;
#pragma unroll
    for (int ir = 0; ir < 8; ++ir) { const int n = 8 * ir + nr; const u32x4 o = *(const LAS u32x4*)(tile + n * 32 + ((kc ^ ((n >> 2) & 7)) * 4));
        *(u32x4*)(WT + (size_t)(drow0 + n) * ldk + k0 + 8 * kc) = o; }
    LDS_WAIT();
}
__device__ __forceinline__ void tr_item8(const float* W, int N, const float* ks, float mul, unsigned char* WT, int ldk, int k0, int n0, int drow0, LAS unsigned* tile, int lane) {
    const int kq = lane >> 4, nq = lane & 15;
#pragma unroll
    for (int h = 0; h < 2; ++h) {
        f32x4 v[4][4];
#pragma unroll
        for (int i2 = 0; i2 < 4; ++i2)
#pragma unroll
            for (int s = 0; s < 4; ++s) v[i2][s] = __builtin_nontemporal_load((const f32x4*)(W + (size_t)(k0 + 64 * h + 16 * i2 + 4 * kq + s) * N + n0 + 4 * nq));
#pragma unroll
        for (int i2 = 0; i2 < 4; ++i2)
#pragma unroll
            for (int s = 0; s < 4; ++s) v[i2][s] = v[i2][s] * (ks ? ks[k0 + 64 * h + 16 * i2 + 4 * kq + s] * mul : mul);
#pragma unroll
        for (int i2 = 0; i2 < 4; ++i2)
#pragma unroll
            for (int j = 0; j < 4; ++j) tile[(4 * nq + j) * 32 + (((4 * h + i2) ^ (nq & 7)) * 4) + kq] = pk4_fp8(v[i2][0][j], v[i2][1][j], v[i2][2][j], v[i2][3][j]);
    }
    LDS_WAIT();
    const int nr = lane >> 3, kc = lane & 7;
#pragma unroll
    for (int ir = 0; ir < 8; ++ir) { const int n = 8 * ir + nr; const u32x4 o = *(const LAS u32x4*)(tile + n * 32 + ((kc ^ ((n >> 2) & 7)) * 4));
        *(u32x4*)(WT + (size_t)(drow0 + n) * ldk + k0 + 16 * kc) = o; }
    LDS_WAIT();
}
__device__ __forceinline__ int map_glu(int n0, int half) { return (n0 < half) ? 256 * (n0 / 128) + (n0 % 128) : 256 * ((n0 - half) / 128) + 128 + ((n0 - half) % 128); }

__device__ __forceinline__ void p0_pre(const Frame& F) {
    PHASE_IDS();
    const float* x = in_ptr(0); const float* g1 = in_ptr(1); const float* w_in = in_ptr(2); const float* g2 = in_ptr(12); const float* w_r = in_ptr(13);
    unsigned char* ws = F.ws;
    LAS unsigned* tile = (LAS unsigned*)(F.lds + wave * 8192);
    const int gw = F.bx * NWAVES + wave, NGW = F.G * NWAVES;
#define P0_LOAD(v, row_) do { const f32x4* xr = (const f32x4*)(x + (size_t)(row_) * D) + lane; _Pragma("unroll") for (int j = 0; j < 8; ++j) v[j] = __builtin_nontemporal_load(xr + 64 * j); } while (0)
#define P0_ROW(v, row_) do { float s = 0.f; \
        _Pragma("unroll") for (int j = 0; j < 8; ++j) s += (v[j][0] * v[j][0] + v[j][1] * v[j][1]) + (v[j][2] * v[j][2] + v[j][3] * v[j][3]); \
        s = wave_sum(s); \
        if (lane == 0) ((float*)(ws + WS_RS1))[row_] = 1.0f / sqrtf(s * (1.0f / D) + EPS); \
        u32x2* o = (u32x2*)((bf16_t*)(ws + WS_XB) + (size_t)(row_) * D) + lane; \
        _Pragma("unroll") for (int j = 0; j < 8; ++j) { u32x2 w; w.x = cvt_pk_bf16(v[j][0], v[j][1]); w.y = cvt_pk_bf16(v[j][2], v[j][3]); o[64 * j] = w; } \
        unsigned* o8 = (unsigned*)(ws + WS_XB8 + (size_t)(row_) * D) + lane; \
        _Pragma("unroll") for (int j = 0; j < 8; ++j) o8[64 * j] = pk4_fp8(v[j][0] * XS, v[j][1] * XS, v[j][2] * XS, v[j][3] * XS); } while (0)
    if (NGW * 8 == T) {
        f32x4 va[8], vb[8];
        P0_LOAD(va, gw);
#pragma unroll
        for (int i = 0; i < 8; i += 2) {
            asm volatile("" ::: "memory"); P0_LOAD(vb, gw + (i + 1) * NGW); asm volatile("" ::: "memory"); P0_ROW(va, gw + i * NGW);
            asm volatile("" ::: "memory"); if (i + 2 < 8) P0_LOAD(va, gw + (i + 2) * NGW); asm volatile("" ::: "memory"); P0_ROW(vb, gw + (i + 1) * NGW);
        }
    } else {
        for (int row = gw; row < T; row += NGW) { f32x4 v[8]; P0_LOAD(v, row); P0_ROW(v, row); }
    }
#undef P0_LOAD
#undef P0_ROW
    for (int idx = (F.bx * NTHREADS + tid); idx < NE * D; idx += F.G * NTHREADS) {
        const int e = idx >> 11, k = idx & 2047; const float val = w_r[k * NE + e] * g2[k];
        const unsigned hi = f2bf(val); const unsigned lo = f2bf(val - bf2f(hi));
        ((bf16_t*)(ws + WS_WRT))[idx] = (bf16_t)hi; ((bf16_t*)(ws + WS_WRT))[NE * D + idx] = (bf16_t)lo;
    }
    constexpr int I_A = (D / 64) * (3072 / 64), I_B = (D / 128) * (4096 / 64);
    for (int r = gw; r < I_A + I_B; r += NGW) {
        if (r < I_A) { const int nb = 3072 / 64, kb = r / nb, n0 = (r % nb) * 64; const int dr = (n0 < 2048) ? map_glu(n0, 1024) : n0;
            tr_item(w_in, NIN, g1, (bf16_t*)(ws + WS_WIN), D, kb * 64, n0, dr, tile, lane); }
        else { const int q = r - I_A, kb = q >> 6, n0 = (q & 63) * 64;
            tr_item8(w_in + 3072, NIN, g1, WSCALE, ws + WS_WIN8, D, kb * 128, n0, map_glu(n0, 2048), tile, lane); }
    }
}
constexpr int Q_CO = (CC / 64) * (D / 64), Q_PO = Q_CO, Q_PW = 4 * 16, Q_O = (D / 64) * (D / 64);
constexpr int Q_W1E = (D / 128) * (4096 / 64), Q_W2E = (DE / 128) * (D / 64);
constexpr int Q_SMALL = Q_CO + Q_O;
__device__ __forceinline__ int q_small_map(int i) { return i < Q_CO ? i : i + Q_PO + Q_PW; }
constexpr int Q_TOTAL = Q_SMALL + NE * (Q_W1E + Q_W2E);
static_assert(Q_SMALL % 2 == 0, "queue chunking");
__device__ __forceinline__ void conv_item(unsigned char* ws, int r, LAS unsigned* tile, int lane) {
    if (r < Q_CO) { const int nb = D / 64, kb = r / nb, n0 = (r % nb) * 64; tr_item(in_ptr(7), D, nullptr, (bf16_t*)(ws + WS_WCO), CC, kb * 64, n0, n0, tile, lane); return; } r -= Q_CO;
    if (r < Q_PO) { const int nb = D / 64, kb = r / nb, n0 = (r % nb) * 64; tr_item(in_ptr(10), D, nullptr, (bf16_t*)(ws + WS_WPO), CC, kb * 64, n0, n0, tile, lane); return; } r -= Q_PO;
    if (r < Q_PW) { const int g = r >> 4, q = r & 15, k0 = (q >> 2) * 64, j0 = (q & 3) * 64;
        const float* pw = in_ptr(8) + (size_t)g * 65536; const float* ps = in_ptr(9) + g * 256; bf16_t* o = (bf16_t*)(ws + WS_WPW) + (size_t)g * 65536;
        const int jj = j0 + 4 * (lane & 15); const f32x4 sc = *(const f32x4*)(ps + jj);
#pragma unroll
        for (int i = 0; i < 16; ++i) { const int k = k0 + 4 * i + (lane >> 4); const f32x4 v = *(const f32x4*)(pw + k * 256 + jj) * sc; u32x2 w; w.x = cvt_pk_bf16(v[0], v[1]); w.y = cvt_pk_bf16(v[2], v[3]); *(u32x2*)(o + k * 256 + jj) = w; }
        return; } r -= Q_PW;
    if (r < Q_O) { const int nb = D / 64, kb = r / nb, n0 = (r % nb) * 64; tr_item(in_ptr(11), D, nullptr, (bf16_t*)(ws + WS_WO), D, kb * 64, n0, n0, tile, lane); return; } r -= Q_O;
    if (r < NE * Q_W1E) { const int e = r / Q_W1E, q = r % Q_W1E; const int nb = 4096 / 64, kb = q / nb, n0 = (q % nb) * 64;
        tr_item8(in_ptr(15) + (size_t)e * D * 4096, 4096, nullptr, WSCALE, ws + WS_W1 + (size_t)e * 4096 * D, D, kb * 128, n0, map_glu(n0, 2048), tile, lane); return; } r -= NE * Q_W1E;
    { const int e = r / Q_W2E, q = r % Q_W2E; const int nb = D / 64, kb = q / nb, n0 = (q % nb) * 64;
        tr_item8(in_ptr(17) + (size_t)e * DE * D, D, nullptr, WSCALE, ws + WS_W2 + (size_t)e * D * DE, DE, kb * 128, n0, n0, tile, lane); }
}
__device__ __forceinline__ void p0_pool_weights(const Frame& F) {
    PHASE_IDS();
    LAS unsigned* tile = (LAS unsigned*)(F.lds + wave * 8192);
    for (int r = F.bx * NWAVES + wave; r < Q_PO + Q_PW; r += F.G * NWAVES) conv_item(F.ws, Q_CO + r, tile, lane);
}
constexpr int QP_W1E = (D / 128) * (4096 / 128), QP_W2E = (DE / 128) * (D / 128);
constexpr int QC_SMALL = Q_SMALL / 2, QC_TOTAL = QC_SMALL + NE * (QP_W1E + QP_W2E);
struct QDesc { const float* W; unsigned char* WT; int N, ldk, k0, n0, drow0; };
__device__ __forceinline__ QDesc q_decode(unsigned char* ws, int r, const float* w1, const float* w2) {
    QDesc d;
    if (r < NE * QP_W1E) { const int e = r / QP_W1E, q = r % QP_W1E, kb = q >> 5, n0 = (q & 31) * 128;
        d.W = w1 + (size_t)e * D * 4096; d.WT = ws + WS_W1 + (size_t)e * 4096 * D; d.N = 4096; d.ldk = D; d.k0 = kb * 128; d.n0 = n0; d.drow0 = map_glu(n0, 2048); }
    else { r -= NE * QP_W1E; const int e = r / QP_W2E, q = r % QP_W2E, kb = q >> 4, n0 = (q & 15) * 128;
        d.W = w2 + (size_t)e * DE * D; d.WT = ws + WS_W2 + (size_t)e * D * DE; d.N = D; d.ldk = DE; d.k0 = kb * 128; d.n0 = n0; d.drow0 = n0; }
    return d;
}
__device__ __forceinline__ const float* q_base(const QDesc& d, int lane) { return d.W + (size_t)(d.k0 + 4 * (lane >> 5)) * d.N + d.n0 + 4 * (lane & 31); }
template <int E> __device__ __forceinline__ void q_load(f32x4 (&v)[8], const float* pb, int N) {
#pragma unroll
    for (int i = 0; i < 8; ++i) { const float* p = pb + (size_t)((16 * E + 8 * (i >> 2) + (i & 3)) * N);
        asm volatile("global_load_dwordx4 %0, %1, off nt" : "=v"(v[i]) : "v"(p) : "memory"); }
}
template <int N> __device__ __forceinline__ void q_wait(f32x4 (&v)[8]) {
    asm volatile("s_waitcnt vmcnt(%8)" : "+v"(v[0]), "+v"(v[1]), "+v"(v[2]), "+v"(v[3]), "+v"(v[4]), "+v"(v[5]), "+v"(v[6]), "+v"(v[7]) : "n"(N) : "memory");
}
template <int E> __device__ __forceinline__ void q_proc(const f32x4 (&v)[8], LAS unsigned* tile, int lane) {
    const int kq = lane >> 5, nq = lane & 31;
#pragma unroll
    for (int h = 0; h < 2; ++h) {
#pragma unroll
        for (int j = 0; j < 4; ++j) tile[(4 * nq + j) * 32 + ((E ^ (nq & 7)) * 4) + 2 * h + kq] = pk4_fp8(v[4 * h][j] * WSCALE, v[4 * h + 1][j] * WSCALE, v[4 * h + 2][j] * WSCALE, v[4 * h + 3][j] * WSCALE); }
}
__device__ __forceinline__ void q_readout(const QDesc& d, LAS unsigned* tile, int lane) {
    LDS_WAIT();
    const int nr = lane >> 3, kc = lane & 7;
#pragma unroll
    for (int ir = 0; ir < 16; ++ir) { const int n = 8 * ir + nr; const u32x4 o = *(const LAS u32x4*)(tile + n * 32 + ((kc ^ ((n >> 2) & 7)) * 4));
        __builtin_nontemporal_store(o, (u32x4*)(d.WT + (size_t)(d.drow0 + n) * d.ldk + d.k0 + 16 * kc)); }
    LDS_WAIT();
}
constexpr int QG_SMALL = QC_SMALL / 8, QG_TOTAL = QC_TOTAL / 8;
static_assert(QC_SMALL % 8 == 0 && QC_TOTAL % 8 == 0, "queue grouping");
__device__ __forceinline__ void conv_queue(const Frame& F) {
    PHASE_IDS();
    unsigned* qhead = (unsigned*)(F.ws + WS_CTL) + CW_QHEAD;
    LAS unsigned* tile = (LAS unsigned*)(F.lds + wave * 16384);
    volatile LAS int* slot = (volatile LAS int*)(F.lds + L_UNITS);
    int it = 0;
    if (tid == 0) slot[0] = (int)__hip_atomic_fetch_add(qhead, 1u, __ATOMIC_RELAXED, __HIP_MEMORY_SCOPE_AGENT);
    __syncthreads();
    int g = __builtin_amdgcn_readfirstlane(slot[0]);
    while (g < QG_SMALL) {
        if (tid == 0) slot[(it + 1) & 1] = (int)__hip_atomic_fetch_add(qhead, 1u, __ATOMIC_RELAXED, __HIP_MEMORY_SCOPE_AGENT);
        const int c = 8 * g + wave; conv_item(F.ws, q_small_map(2 * c), tile, lane); conv_item(F.ws, q_small_map(2 * c + 1), tile, lane);
        __syncthreads();
        g = __builtin_amdgcn_readfirstlane(slot[(it + 1) & 1]); ++it;
    }
    if (g >= QG_TOTAL) return;
    const float* w1 = in_ptr(15); const float* w2 = in_ptr(17);
    if (tid == 0) slot[(it + 1) & 1] = (int)__hip_atomic_fetch_add(qhead, 1u, __ATOMIC_RELAXED, __HIP_MEMORY_SCOPE_AGENT);
    __syncthreads();
    int gnext = __builtin_amdgcn_readfirstlane(slot[(it + 1) & 1]); ++it;
    QDesc d = q_decode(F.ws, 8 * g + wave - QC_SMALL, w1, w2);
    f32x4 v0[8], v1[8], v2[8], v3[8];
    unsigned pend2 = 0u;
    const float* pd = q_base(d, lane);
    q_load<0>(v0, pd, d.N); q_load<1>(v1, pd, d.N); q_load<2>(v2, pd, d.N);
#define Q_FENCE() do { asm volatile("" ::: "memory"); __builtin_amdgcn_sched_barrier(0); } while (0)
    for (;;) {
        const int nr = (gnext < QG_TOTAL) ? 8 * gnext + wave : -1;
        if (nr >= 0) { if (tid == 0) asm volatile("global_atomic_add %0, %1, %2, %3 sc0" : "=v"(pend2) : "v"(0), "v"(1), "s"(qhead) : "memory"); }
        const QDesc dn = (nr >= 0) ? q_decode(F.ws, nr - QC_SMALL, w1, w2) : d;
        const float* pn = q_base(dn, lane);
        Q_FENCE(); q_load<3>(v3, pd, d.N);  Q_FENCE(); q_wait<24>(v0); q_proc<0>(v0, tile, lane);
        Q_FENCE(); q_load<4>(v0, pd, d.N);  Q_FENCE(); q_wait<24>(v1); q_proc<1>(v1, tile, lane);
        Q_FENCE(); q_load<5>(v1, pd, d.N);  Q_FENCE(); q_wait<24>(v2); q_proc<2>(v2, tile, lane);
        Q_FENCE(); q_load<6>(v2, pd, d.N);  Q_FENCE(); q_wait<24>(v3); q_proc<3>(v3, tile, lane);
        Q_FENCE(); q_load<7>(v3, pd, d.N);  Q_FENCE(); q_wait<24>(v0); q_proc<4>(v0, tile, lane);
        Q_FENCE(); q_load<0>(v0, pn, dn.N); Q_FENCE(); q_wait<24>(v1); q_proc<5>(v1, tile, lane);
        Q_FENCE(); q_load<1>(v1, pn, dn.N); Q_FENCE(); q_wait<24>(v2); q_proc<6>(v2, tile, lane);
        Q_FENCE(); q_load<2>(v2, pn, dn.N); Q_FENCE(); q_wait<24>(v3); q_proc<7>(v3, tile, lane);
        Q_FENCE(); q_readout(d, tile, lane); Q_FENCE();
        if (nr < 0) break;
        if (tid == 0) { asm volatile("s_waitcnt vmcnt(24)" : "+v"(pend2) :: "memory"); slot[(it + 1) & 1] = (int)pend2; }
        LDS_WAIT(); Q_FENCE(); __builtin_amdgcn_s_barrier(); Q_FENCE();
        gnext = __builtin_amdgcn_readfirstlane(slot[(it + 1) & 1]); ++it;
        d = dn; pd = pn;
    }
    asm volatile("s_waitcnt vmcnt(0)" ::: "memory");
#undef Q_FENCE
}

template <int W> __device__ __forceinline__ void pool_item(const unsigned (&pr)[31], bf16_t* DP, int t0, int s0, int c0) {
#pragma unroll
    for (int o = 0; o < 16; ++o) { float a0 = 0.f, a1 = 0.f;
#pragma unroll
        for (int j = 0; j < W; ++j) { a0 += bflo(pr[15 + o - j]); a1 += bfhi(pr[15 + o - j]); }
        const int pos = s0 + o + 1; const float inv = 1.0f / (float)(pos < W ? pos : W);
        *(unsigned*)(DP + (size_t)(t0 + o) * CC + c0) = cvt_pk_bf16(a0 * inv - bflo(pr[15 + o]), a1 * inv - bfhi(pr[15 + o])); }
}
__device__ __forceinline__ void p2_conv_pool(const Frame& F, const Args& a) {
    PHASE_IDS();
    const float* conv_w = in_ptr(3); const float* conv_b = in_ptr(4); const float* ln_g = in_ptr(5); const float* ln_b = in_ptr(6);
    const bf16_t* U = (const bf16_t*)(F.ws + WS_U); const bf16_t* P = (const bf16_t*)(F.ws + WS_P);
    bf16_t* AC = (bf16_t*)(F.ws + WS_AC); bf16_t* DP = (bf16_t*)(F.ws + WS_DP);
    const int c0 = 2 * tid;
    f32x2 wv[31];
#pragma unroll
    for (int j = 0; j < 31; ++j) wv[j] = *(const f32x2*)(conv_w + j * CC + c0);
    const f32x2 cb = *(const f32x2*)(conv_b + c0), lg = *(const f32x2*)(ln_g + c0), lb = *(const f32x2*)(ln_b + c0);
    const int gi = wave >> 1;
    int par = 0;
    unsigned pr[31], ur[46], ur2[46];
#define P2_LOADP(PR, it) do { const int t0_ = (it) * 16, s0_ = t0_ & (SEQ - 1); \
        _Pragma("unroll") for (int r = 0; r < 31; ++r) { PR[r] = 0u; if (s0_ - 15 + r >= 0) PR[r] = *(const unsigned*)(P + (size_t)(t0_ - 15 + r) * CC + c0); } } while (0)
#define P2_LOADU(UR, it) do { const int t0_ = (it) * 16, s0_ = t0_ & (SEQ - 1); \
        _Pragma("unroll") for (int r = 0; r < 46; ++r) { UR[r] = 0u; if (s0_ - 30 + r >= 0) UR[r] = *(const unsigned*)(U + (size_t)(t0_ - 30 + r) * CC + c0); } } while (0)
    if (F.bx < T / 16) P2_LOADU(ur, F.bx);
    for (int item = F.bx; item < T / 16; item += F.G, par ^= 1) {
        LAS float* red = (LAS float*)(F.lds + par * 65536);
        LAS float* tot = (LAS float*)(F.lds + L_TBL + par * 256);
        const int t0 = item * 16, s0 = t0 & (SEQ - 1);
        const int nitem = (item + F.G < T / 16) ? item + F.G : item;
        P2_LOADP(pr, item); P2_LOADU(ur2, nitem);
        asm volatile("" ::: "memory");
        if (gi == 0) pool_item<2>(pr, DP, t0, s0, c0); else if (gi == 1) pool_item<4>(pr, DP, t0, s0, c0); else if (gi == 2) pool_item<8>(pr, DP, t0, s0, c0); else pool_item<16>(pr, DP, t0, s0, c0);
        f32x2 av[16];
#pragma unroll
        for (int o = 0; o < 16; ++o) av[o] = cb;
#pragma unroll
        for (int r = 0; r < 46; ++r) {
            const f32x2 uv = (f32x2){bflo(ur[r]), bfhi(ur[r])};
#pragma unroll
            for (int o = 0; o < 16; ++o) { const int j = r - o; if (j >= 0 && j <= 30) av[o] = __builtin_elementwise_fma(wv[j], uv, av[o]); }
        }
#pragma unroll
        for (int o = 0; o < 16; ++o) { red[o * 512 + tid] = av[o][0] + av[o][1]; red[(16 + o) * 512 + tid] = av[o][0] * av[o][0] + av[o][1] * av[o][1]; }
        __syncthreads();
#pragma unroll
        for (int q = 0; q < 4; ++q) { const int row = wave * 4 + q; float s = 0.f;
#pragma unroll
            for (int i = 0; i < 8; ++i) s += red[row * 512 + lane + 64 * i];
            s = wave_sum(s); if (lane == 0) tot[row] = s; }
        __syncthreads();
#pragma unroll
        for (int o = 0; o < 16; ++o) { const float mean = tot[o] * (1.0f / CC), var = tot[16 + o] * (1.0f / CC) - mean * mean; const float rstd = 1.0f / sqrtf(fmaxf(var, 0.f) + EPS);
            const float y0 = (av[o][0] - mean) * rstd * lg[0] + lb[0], y1 = (av[o][1] - mean) * rstd * lg[1] + lb[1];
            *(unsigned*)(AC + (size_t)(t0 + o) * CC + c0) = cvt_pk_bf16(y0 * sigmoidf_(y0), y1 * sigmoidf_(y1)); }
        asm volatile("" ::: "memory");
#pragma unroll
        for (int r = 0; r < 46; ++r) ur[r] = ur2[r];
    }
#undef P2_LOADP
#undef P2_LOADU
    __syncthreads();
}

__device__ __forceinline__ void p6_router(const Frame& F, const Args& a) {
    PHASE_IDS();
    const float* b_r = in_ptr(14);
    const bf16_t* H = (const bf16_t*)(F.ws + WS_H); const float* SSQP = (const float*)(F.ws + WS_SSQP);
    const bf16_t* WH = (const bf16_t*)(F.ws + WS_WRT); const bf16_t* WL = WH + NE * D;
    int* ltok = (int*)(F.ws + WS_LTOK); float* lgate = (float*)(F.ws + WS_LGATE); float* lrs = (float*)(F.ws + WS_LRS); int* slotref = (int*)(F.ws + WS_SLOTREF);
    unsigned* cnt = (unsigned*)(F.ws + WS_CTL) + CW_CNT;
    const int fr = lane & 15, fq = lane >> 4;
    const int grp = wave & 3, kh = wave >> 2;
    LAS float* lg = (LAS float*)(F.lds + grp * 4096);
    LAS float* part = (LAS float*)(F.lds + 16384 + grp * 2048);
    LAS unsigned* lcnt = (LAS unsigned*)(F.lds + 32768);
    LAS unsigned* gbase = (LAS unsigned*)(F.lds + 32768 + 128);
    for (int item = F.bx; item < T / 64; item += F.G) {
        const int t0 = item * 64 + grp * 16;
        const bf16_t* hrow = H + (size_t)(t0 + fr) * D + 8 * fq + kh * 1024;
        const bf16_t* wh = WH + (size_t)fr * D + 8 * fq + kh * 1024; const bf16_t* wl = WL + (size_t)fr * D + 8 * fq + kh * 1024;
        f32x4 acc0 = (f32x4){0.f, 0.f, 0.f, 0.f}, acc1 = acc0;
        bf16x8 hb[4][2], ah[4][2], bh[4][2], al[4][2], bl[4][2];
        const bf16_t* pA = wh; const bf16_t* pB = wh + 16 * D; const bf16_t* pC = wl; const bf16_t* pD = wl + 16 * D; const bf16_t* pH = hrow;
        asm volatile("" : "+v"(pA), "+v"(pB), "+v"(pC), "+v"(pD), "+v"(pH));
#define R_LOAD(buf, s0) do { _Pragma("unroll") for (int i = 0; i < 2; ++i) { const int o = 32 * ((s0) + i); hb[buf][i] = *(const bf16x8*)(pH + o); ah[buf][i] = *(const bf16x8*)(pA + o); bh[buf][i] = *(const bf16x8*)(pB + o); \
            al[buf][i] = *(const bf16x8*)(pC + o); bl[buf][i] = *(const bf16x8*)(pD + o); } } while (0)
#define R_FENCE() do { asm volatile("" ::: "memory"); __builtin_amdgcn_sched_barrier(0); } while (0)
        R_LOAD(0, 0); R_LOAD(1, 2); R_LOAD(2, 4); R_FENCE();
#pragma unroll
        for (int b = 0; b < 16; ++b) {
            if (b + 3 < 16) R_LOAD((b + 3) & 3, 2 * (b + 3));
            R_FENCE();
#pragma unroll
            for (int i = 0; i < 2; ++i) {
                acc0 = __builtin_amdgcn_mfma_f32_16x16x32_bf16(ah[b & 3][i], hb[b & 3][i], acc0, 0, 0, 0); acc0 = __builtin_amdgcn_mfma_f32_16x16x32_bf16(al[b & 3][i], hb[b & 3][i], acc0, 0, 0, 0);
                acc1 = __builtin_amdgcn_mfma_f32_16x16x32_bf16(bh[b & 3][i], hb[b & 3][i], acc1, 0, 0, 0); acc1 = __builtin_amdgcn_mfma_f32_16x16x32_bf16(bl[b & 3][i], hb[b & 3][i], acc1, 0, 0, 0);
            }
            R_FENCE();
        }
#undef R_LOAD
#undef R_FENCE
        if (kh == 1) { *(LAS f32x4*)(part + lane * 8) = acc0; *(LAS f32x4*)(part + lane * 8 + 4) = acc1; }
        if (tid < NE) lcnt[tid] = 0u;
        __syncthreads();
        float p[4] = {0.f, 0.f, 0.f, 0.f}; int ti[4] = {0, 0, 0, 0}; unsigned lpos[4] = {0u, 0u, 0u, 0u}; float inv = 0.f, rs_tok = 0.f;
        if (kh == 0) {
        acc0 = acc0 + *(const LAS f32x4*)(part + lane * 8); acc1 = acc1 + *(const LAS f32x4*)(part + lane * 8 + 4);
        float ss = 0.f;
#pragma unroll
        for (int i = 0; i < 8; ++i) { const f32x4 pp = *(const f32x4*)(SSQP + (size_t)(t0 + fr) * 32 + 4 * i); ss += (pp[0] + pp[1]) + (pp[2] + pp[3]); }
        const float rs = 1.0f / sqrtf(ss * (1.0f / D) + EPS);
#pragma unroll
        for (int j = 0; j < 4; ++j) { lg[fr * 33 + 4 * fq + j] = acc0[j] * rs + b_r[4 * fq + j]; lg[fr * 33 + 16 + 4 * fq + j] = acc1[j] * rs + b_r[16 + 4 * fq + j]; }
        LDS_WAIT(); __builtin_amdgcn_wave_barrier();
        if (lane < 16) {
            float v[32];
#pragma unroll
            for (int e = 0; e < 32; ++e) v[e] = lg[lane * 33 + e];
            float tv[4];
#pragma unroll
            for (int k = 0; k < 4; ++k) { float best = -3.0e38f; int bi = 0;
#pragma unroll
                for (int e = 0; e < 32; ++e) if (v[e] > best) { best = v[e]; bi = e; }
                tv[k] = best; ti[k] = bi;
#pragma unroll
                for (int e = 0; e < 32; ++e) v[e] = (e == bi) ? -3.0e38f : v[e]; }
            float sum = 0.f;
#pragma unroll
            for (int k = 0; k < 4; ++k) { p[k] = __expf(tv[k] - tv[0]); sum += p[k]; }
            inv = 1.0f / sum; rs_tok = rs;
#pragma unroll
            for (int k = 0; k < 4; ++k) lpos[k] = __hip_atomic_fetch_add(lcnt + ti[k], 1u, __ATOMIC_RELAXED, __HIP_MEMORY_SCOPE_WORKGROUP);
        }
        }
        __syncthreads();
        if (tid < NE) { const unsigned c = lcnt[tid]; gbase[tid] = c ? __hip_atomic_fetch_add(cnt + 64 * tid, c, __ATOMIC_RELAXED, __HIP_MEMORY_SCOPE_AGENT) : 0u; }
        __syncthreads();
        if (kh == 0 && lane < 16) { const int tok = t0 + lane;
#pragma unroll
            for (int k = 0; k < 4; ++k) { const int e = ti[k]; const unsigned pos = gbase[e] + lpos[k];
                ltok[e * LCAP + pos] = tok; lgate[e * LCAP + pos] = p[k] * inv; lrs[e * LCAP + pos] = rs_tok; slotref[tok * 4 + k] = (e << 16) | (int)pos; }
        }
        __syncthreads();
    }
}

__device__ __forceinline__ void moe_prepare(const Frame& F) {
    PHASE_IDS();
    unsigned* cnt = (unsigned*)(F.ws + WS_CTL) + CW_CNT;
    LAS int* lc = (LAS int*)(F.lds + L_CNT); LAS int* lb = (LAS int*)(F.lds + L_BASE); LAS int* ln = (LAS int*)(F.lds + L_NRT);
    __syncthreads();
    if (tid < NE) { const int c = (int)__hip_atomic_load(cnt + 64 * tid, __ATOMIC_RELAXED, __HIP_MEMORY_SCOPE_AGENT); lc[tid] = c; ln[tid] = (c + 255) >> 8; }
    __syncthreads();
    if (tid < NE) { int b = 0; for (int e = 0; e < NE; ++e) { const int v = ln[e]; b += (e < tid) ? v : 0; } lb[tid] = b * 256; }
    __syncthreads();
}
template <int NCB, int CPB  , bool GLOBAL> __device__ __forceinline__ void moe_build_units(const Frame& F) {
    PHASE_IDS();
    LAS int* ln = (LAS int*)(F.lds + L_NRT); LAS int* lu = (LAS int*)(F.lds + L_UNITS); LAS int* lnu = (LAS int*)(F.lds + L_NU);
    constexpr int EM = 8 / NCB;
    if (GLOBAL && F.G == 256) {
        const int j = (F.bx % 8) * 32 + F.bx / 8;
        int code = 0; bool has = false;
        if (tid < NE * NCB) { const int e = tid / NCB, cb = tid % NCB; int pre = 0;
            for (int e2 = 0; e2 < NE; ++e2) { const int v = ln[e2]; pre += (e2 < e) ? v : 0; }
            const int nrt = ln[e], n = nrt * CPB, pos = (pre * NCB + cb * nrt) * CPB, q = (j - pos) & 255;
            has = q < n; code = (e << 16) | ((q / CPB) << 8) | (cb * CPB + q % CPB); }
        const unsigned long long m = __ballot(has);
        if (tid == 0) lnu[1] = __popcll(m);
        __syncthreads();
        if (tid < NE * NCB) { const int off = (wave == 1) ? lnu[1] : 0;
            if (has) lu[off + __popcll(m & ((1ull << lane) - 1ull))] = code;
            if (tid == 64) lnu[0] = off + __popcll(m); }
        __syncthreads();
        return;
    }
    if (tid == 0) {
        const int NS = (F.G % 8 == 0 && !GLOBAL) ? 8 : 1; const int x = F.bx % NS;
        const int j = GLOBAL ? ((F.G % 8 == 0) ? (F.bx % 8) * (F.G / 8) + F.bx / 8 : F.bx) : F.bx / NS, nj = F.G / NS;
        int p = 0, nu = 0;
        for (int e = 0; e < NE; ++e) {
            for (int cb = 0; cb < NCB; ++cb) {
                if (NS == 8) { if ((e % EM) != (x % EM)) continue; if (cb != (((e / EM) + (x / EM)) % NCB)) continue; }
                const int n = ln[e] * CPB;
                int q = (j - (p % nj) + nj) % nj;
                for (; q < n; q += nj) { const int rt = q / CPB, c4 = q % CPB; if (nu < 256) lu[nu++] = (e << 16) | (rt << 8) | (cb * CPB + c4); }
                p += n;
            }
        }
        lnu[0] = nu;
    }
    __syncthreads();
}

__device__ __forceinline__ void p9_combine(const Frame& F, const Args& a) {
    PHASE_IDS();
    const float* gf = in_ptr(19); const bf16_t* H = (const bf16_t*)(F.ws + WS_H); const unsigned char* Y = (const unsigned char*)(F.ws + WS_Y); const int* slotref = (const int*)(F.ws + WS_SLOTREF);
    const LAS int* lb = (const LAS int*)(F.lds + L_BASE);
    const int gw = F.bx * NWAVES + wave, NGW = F.G * NWAVES;
    float* out = out_ptr();
    f32x4 gv[8];
#pragma unroll
    for (int q = 0; q < 8; ++q) gv[q] = ((const f32x4*)gf)[lane + 64 * q];
#define P9_ISSUE(hb, yb, tok_, sr_) do { _Pragma("unroll") for (int q = 0; q < 8; ++q) hb[q] = ((const u32x2*)(H + (size_t)(tok_) * D))[lane + 64 * q]; \
        _Pragma("unroll") for (int k = 0; k < 4; ++k) { const int sr = (sr_)[k]; const int slot = lb[sr >> 16] + (sr & 0xffff); const unsigned* yr = (const unsigned*)(Y + (size_t)slot * D) + lane; \
            _Pragma("unroll") for (int q = 0; q < 8; ++q) yb[k][q] = yr[64 * q]; } } while (0)
#define P9_FIN(hb, yb, tok_) do { f32x4 v[8]; \
        _Pragma("unroll") for (int q = 0; q < 8; ++q) v[q] = (f32x4){bflo(hb[q].x), bfhi(hb[q].x), bflo(hb[q].y), bfhi(hb[q].y)}; \
        _Pragma("unroll") for (int k = 0; k < 4; ++k) _Pragma("unroll") for (int q = 0; q < 8; ++q) { const unsigned w = yb[k][q]; const f32x2 lo = __builtin_amdgcn_cvt_pk_f32_fp8((int)w, false), hi = __builtin_amdgcn_cvt_pk_f32_fp8((int)w, true); \
            v[q][0] += lo[0] * (1.0f / YSCALE); v[q][1] += lo[1] * (1.0f / YSCALE); v[q][2] += hi[0] * (1.0f / YSCALE); v[q][3] += hi[1] * (1.0f / YSCALE); } \
        float s = 0.f; \
        _Pragma("unroll") for (int q = 0; q < 8; ++q) s += (v[q][0] * v[q][0] + v[q][1] * v[q][1]) + (v[q][2] * v[q][2] + v[q][3] * v[q][3]); \
        s = wave_sum(s); const float rs = 1.0f / sqrtf(s * (1.0f / D) + EPS); \
        _Pragma("unroll") for (int q = 0; q < 8; ++q) __builtin_nontemporal_store(v[q] * rs * gv[q], (f32x4*)(out + (size_t)(tok_) * D) + lane + 64 * q); } while (0)
#define P9_FENCE() asm volatile("" ::: "memory")
    if (NGW * 8 == T) {
        i32x4 srs[8];
#pragma unroll
        for (int i = 0; i < 8; ++i) srs[i] = *(const i32x4*)(slotref + (gw + i * NGW) * 4);
        u32x2 hA[8], hB[8]; unsigned yA[4][8], yB[4][8];
        P9_ISSUE(hA, yA, gw, srs[0]);
#pragma unroll
        for (int i = 0; i < 8; i += 2) {
            P9_FENCE(); P9_ISSUE(hB, yB, gw + (i + 1) * NGW, srs[i + 1]); P9_FENCE(); P9_FIN(hA, yA, gw + i * NGW);
            P9_FENCE(); if (i + 2 < 8) P9_ISSUE(hA, yA, gw + (i + 2) * NGW, srs[i + 2]); P9_FENCE(); P9_FIN(hB, yB, gw + (i + 1) * NGW);
        }
        return;
    }
#undef P9_ISSUE
#undef P9_FIN
#undef P9_FENCE
    for (int tok = gw; tok < T; tok += NGW) {
        f32x4 v[8];
#pragma unroll
        for (int q = 0; q < 8; ++q) { const u32x2 w = ((const u32x2*)(H + (size_t)tok * D))[lane + 64 * q]; v[q] = (f32x4){bflo(w.x), bfhi(w.x), bflo(w.y), bfhi(w.y)}; }
        const i32x4 sr4 = *(const i32x4*)(slotref + tok * 4);
#pragma unroll
        for (int k = 0; k < 4; ++k) { const int sr = sr4[k]; const int slot = lb[sr >> 16] + (sr & 0xffff);
            const unsigned* yr = (const unsigned*)(Y + (size_t)slot * D) + lane;
#pragma unroll
            for (int q = 0; q < 8; ++q) { const unsigned w = yr[64 * q]; const f32x2 lo = __builtin_amdgcn_cvt_pk_f32_fp8((int)w, false), hi = __builtin_amdgcn_cvt_pk_f32_fp8((int)w, true);
                v[q][0] += lo[0] * (1.0f / YSCALE); v[q][1] += lo[1] * (1.0f / YSCALE); v[q][2] += hi[0] * (1.0f / YSCALE); v[q][3] += hi[1] * (1.0f / YSCALE); } }
        float s = 0.f;
#pragma unroll
        for (int q = 0; q < 8; ++q) s += (v[q][0] * v[q][0] + v[q][1] * v[q][1]) + (v[q][2] * v[q][2] + v[q][3] * v[q][3]);
        s = wave_sum(s); const float rs = 1.0f / sqrtf(s * (1.0f / D) + EPS);
#pragma unroll
        for (int q = 0; q < 8; ++q) __builtin_nontemporal_store(v[q] * rs * gv[q], (f32x4*)(out + (size_t)tok * D) + lane + 64 * q);
    }
}

constexpr int NPH = 10;
__global__ void __launch_bounds__(NTHREADS, 2) fwd(Args args) {
    extern __shared__ __attribute__((aligned(16))) unsigned char lds_raw[];
    Frame F; F.lds = (LAS unsigned char*)lds_raw; F.ws = args.ws;
    F.G = gridDim.x; F.bx = blockIdx.x;
    { const int t0 = tid_opaque(); for (int u = t0; u < (LDS_BYTES - STAGE_BYTES) / 4; u += NTHREADS) ((LAS unsigned*)(F.lds + STAGE_BYTES))[u] = 0u; }
    __syncthreads();
    unsigned* ctl = (unsigned*)(args.ws + WS_CTL);
    XcdBarrier bar; bar.bar = ctl + CW_BAR; bar.x = 0; bar.st = nullptr;
    if (N_LAUNCHES == 1) bar = xcd_barrier_post(ctl + CW_BAR, (volatile LAS unsigned*)(F.lds + L_MISC) + 8);
    const int lo = args.ph_lo, hi = args.ph_hi;
#define IN(k) (lo <= (k) && (k) < hi)
#define SEAM(k) do { if (IN(k) && IN((k) + 1)) xcd_barrier(bar); } while (0)
    unsigned char* ws = args.ws;

    if (IN(0)) { p0_pre(F); p0_pool_weights(F); } SEAM(0);

    if (IN(1)) {
        const bool split = (F.G == 256);
        const int ggemm = split ? 160 : F.G;
        if (F.bx < ggemm) {
            { DenseSched S; S.A = (const char*)(ws + WS_XB); S.B = (const char*)(ws + WS_WIN); S.lda = D; S.ldb = D; S.G = ggemm; S.c = F.bx; S.to.init(T, 3072, 4);
              EpiWin E{(bf16_t*)(ws + WS_U), (bf16_t*)(ws + WS_P), (const float*)(ws + WS_RS1), F.lds};
              gemm_phase<EpiWin, DenseSched, false, false>(F.lds, D * 2, D * 2, S, E); }
            { DenseSched8 S; S.A = (const char*)(ws + WS_XB8); S.B = (const char*)(ws + WS_WIN8); S.lda = D; S.ldb = D; S.G = ggemm; S.c = ggemm - 1 - F.bx; S.to.init(T, 4096, 4);
              EpiGate E{(unsigned char*)(ws + WS_G), (const float*)(ws + WS_RS1), F.lds};
              gemm_phase<EpiGate, DenseSched8, false, true>(F.lds, D, D, S, E); }
            if (split && F.bx >= 8 && F.bx < 40) {
                PoolSched S2; S2.A = (const char*)(ws + WS_WPO); S2.B = (const char*)(ws + WS_WPW); S2.G = 32; S2.c = F.bx - 8;
                EpiPool E2{(bf16_t*)(ws + WS_YP)};
                gemm_phase<EpiPool, PoolSched, false, false>(F.lds, 256 * 2, 256 * 2, S2, E2);
            }
        }
        conv_queue(F);
    } SEAM(1);


    if (IN(2)) {
        if (F.G != 256) { PoolSched S; S.A = (const char*)(ws + WS_WPO); S.B = (const char*)(ws + WS_WPW); S.G = F.G; S.c = F.bx;
          EpiPool E{(bf16_t*)(ws + WS_YP)};
          gemm_phase<EpiPool, PoolSched, false, false>(F.lds, 256 * 2, 256 * 2, S, E); }
        __syncthreads();
        p2_conv_pool(F, args);
    } SEAM(2);

    if (IN(4)) {
        MergeSched S; S.A0 = (const char*)(ws + WS_AC); S.A1 = (const char*)(ws + WS_DP); S.B0 = (const char*)(ws + WS_WCO); S.B1 = (const char*)(ws + WS_YP); S.G = F.G; S.c = F.bx; S.to.init(T, D);
        EpiMerge E{(bf16_t*)(ws + WS_MG), (const unsigned char*)(ws + WS_G)};
        gemm_phase<EpiMerge, MergeSched, false, false>(F.lds, CC * 2, CC * 2, S, E);
    } SEAM(4);

    if (IN(5)) {
        DenseSched S; S.A = (const char*)(ws + WS_MG); S.B = (const char*)(ws + WS_WO); S.lda = D; S.ldb = D; S.G = F.G; S.c = F.bx; S.to.init(T, D);
        EpiWo E{(const bf16_t*)(ws + WS_XB), (bf16_t*)(ws + WS_H), (unsigned char*)(ws + WS_HB), (float*)(ws + WS_SSQP), in_ptr(12)};
        gemm_phase<EpiWo, DenseSched, false, false>(F.lds, D * 2, D * 2, S, E);
    } SEAM(5);

    if (IN(6)) { p6_router(F, args); } SEAM(6);

    if (IN(7)) {
        moe_prepare(F); moe_build_units<4, 4, true>(F);
        MoeSched S; S.lds = F.lds; S.A = (const char*)(ws + WS_HB); S.B = (const char*)(ws + WS_W1); S.ltok = (const int*)(ws + WS_LTOK); S.gather = 1; S.nrows_w = 4096;
        EpiMoe1 E{(unsigned char*)(ws + WS_ACT), in_ptr(16), (const float*)(ws + WS_LRS), F.lds};
        gemm_phase<EpiMoe1, MoeSched, true, true>(F.lds, D, D, S, E);
    } SEAM(7);

    if (IN(8)) {
        if (!IN(7)) moe_prepare(F);
        moe_build_units<4, 2, true>(F);
        MoeSched S; S.lds = F.lds; S.A = (const char*)(ws + WS_ACT); S.B = (const char*)(ws + WS_W2); S.ltok = nullptr; S.gather = 0; S.nrows_w = 2048;
        EpiMoe2 E{(unsigned char*)(ws + WS_Y), in_ptr(18), (const float*)(ws + WS_LGATE), F.lds};
        gemm_phase<EpiMoe2, MoeSched, false, true>(F.lds, DE, DE, S, E);
    } SEAM(8);

    if (IN(9)) { if (!IN(7)) moe_prepare(F); p9_combine(F, args); }
#undef IN
#undef SEAM
}

extern "C" void kernel_launch(void* const* d_in, const int* in_sizes, int n_in, void* d_out, int out_size, void* d_ws, size_t ws_size, hipStream_t stream) {
    static int grid = 0;
    if (grid == 0) {
        if (n_in != 20 || in_sizes[0] != T * D || out_size != T * D || ws_size < WS_END) { fprintf(stderr, "kernel_launch: unexpected shapes (n_in %d, in0 %d, out %d, ws %zu)\n", n_in, n_in > 0 ? in_sizes[0] : -1, out_size, ws_size); grid = -1; return; }
        int dev = 0, cus = 0, per_cu = 0;
        if (hipGetDevice(&dev) != hipSuccess || hipDeviceGetAttribute(&cus, hipDeviceAttributeMultiprocessorCount, dev) != hipSuccess) { grid = -1; return; }
        if (hipFuncSetAttribute((const void*)fwd, hipFuncAttributeMaxDynamicSharedMemorySize, LDS_BYTES) != hipSuccess) { fprintf(stderr, "kernel_launch: hipFuncSetAttribute failed\n"); grid = -1; return; }
        if (hipOccupancyMaxActiveBlocksPerMultiprocessor(&per_cu, (const void*)fwd, NTHREADS, LDS_BYTES) != hipSuccess || per_cu < 1) fprintf(stderr, "kernel_launch: occupancy query says %d\n", per_cu);
        (void)hipGetLastError();
        grid = cus;
    }
    if (grid < 0) return;
    (void)hipMemsetAsync((char*)d_ws + WS_CTL, 0, CTL_ZERO_BYTES, stream);
    Args a{};
    for (int i = 0; i < 20; ++i) a.in[i] = (const float*)d_in[i];
    a.out = (float*)d_out; a.ws = (unsigned char*)d_ws; a.pad = 0;
    if (N_LAUNCHES == 1) { a.ph_lo = 0; a.ph_hi = NPH; a.li = 0; hipLaunchKernelGGL(fwd, dim3(grid), dim3(NTHREADS), LDS_BYTES, stream, a); }
    else for (int p = 0; p < NPH; ++p) { a.ph_lo = p; a.ph_hi = p + 1; a.li = p; hipLaunchKernelGGL(fwd, dim3(grid), dim3(NTHREADS), LDS_BYTES, stream, a); }
}
```
